# Optimizing an MI355X kernel written in HIP

```python
import jax, jax.numpy as jnp
from jax import lax
import numpy as np

D_MODEL = 1024
BATCH = 8
SEQ = 4096
DEPTH = 2

HEAD_DIM = 64
HG_HEADS = 4
HG_WIDTH = HG_HEADS * HEAD_DIM
HG_CHUNK = 64
ATT_HEADS = 8
ATT_KV_HEADS = 2
ATT_WIDTH = ATT_HEADS * HEAD_DIM
ATT_KV_WIDTH = ATT_KV_HEADS * HEAD_DIM
WINDOW = 128
ROPE_THETA = 10000.0
SG_GROUPS = 4
SG_WIDTH = SG_GROUPS * HEAD_DIM
SG_CHUNK = 128

MIX_WIDTH = HG_WIDTH + ATT_WIDTH + SG_WIDTH
IN_SPLITS = (HG_WIDTH, HG_WIDTH, HG_WIDTH, HG_WIDTH,
             ATT_WIDTH, ATT_KV_WIDTH, ATT_KV_WIDTH,
             SG_WIDTH, SG_WIDTH)
IN_WIDTH = sum(IN_SPLITS)
D_FF = 2816
PLE_DIM = 256
N_NORMS = 8
EPS = 1e-6
MASK_VALUE = -1e30
LB_FLOOR = 1e-30

kernel_name = "hybrid_hgrn2_swa_sink_sgu_macaron"


def rmsnorm(x, g):
    xf = x.astype(jnp.float32)
    y = xf * lax.rsqrt(jnp.mean(xf * xf, axis=-1, keepdims=True) + EPS)
    return (y * g.astype(jnp.float32)).astype(x.dtype)


def layernorm(x, g):
    xf = x.astype(jnp.float32)
    mu = jnp.mean(xf, axis=-1, keepdims=True)
    xc = xf - mu
    y = xc * lax.rsqrt(jnp.mean(xc * xc, axis=-1, keepdims=True) + EPS)
    return (y * g.astype(jnp.float32)).astype(x.dtype)


def swiglu(x, w_gu, w_down):
    gate, up = jnp.split(x @ w_gu, 2, axis=-1)
    return (jax.nn.silu(gate) * up) @ w_down


def rope(x, pos):
    half = x.shape[-1] // 2
    inv = ROPE_THETA ** (-jnp.arange(half, dtype=jnp.float32) / half)
    ang = pos.astype(jnp.float32)[..., None] * inv
    cos = jnp.cos(ang)[:, :, None, :]
    sin = jnp.sin(ang)[:, :, None, :]
    xf = x.astype(jnp.float32)
    x1, x2 = xf[..., :half], xf[..., half:]
    return jnp.concatenate([x1 * cos - x2 * sin, x2 * cos + x1 * sin], axis=-1).astype(x.dtype)


def hgrn2(q, f_raw, i, lb):
    B, S, _ = q.shape
    C = HG_CHUNK
    n = S // C
    q = q.astype(jnp.float32)
    v = i.astype(jnp.float32)
    lb = lb.astype(jnp.float32)
    logf = jnp.logaddexp(jnp.log(jnp.maximum(lb, LB_FLOOR)),
                         jnp.log1p(-lb) + jax.nn.log_sigmoid(f_raw.astype(jnp.float32)))
    k = -jnp.expm1(logf)

    def heads(t):
        return t.reshape(B, n, C, HG_HEADS, HEAD_DIM).transpose(1, 0, 3, 2, 4)

    causal = jnp.tril(jnp.ones((C, C), dtype=bool))[:, :, None]

    def step(state, inp):
        qc, kc, vc, lc = inp
        b = jnp.cumsum(lc, axis=2)
        o_inter = jnp.einsum('bhcd,bhde->bhce', qc * jnp.exp(b), state)
        diff = b[:, :, :, None, :] - b[:, :, None, :, :]
        dec = jnp.where(causal, jnp.exp(jnp.where(causal, diff, 0.0)), 0.0)
        att = jnp.einsum('bhid,bhjd,bhijd->bhij', qc, kc, dec)
        o_intra = jnp.einsum('bhij,bhje->bhie', att, vc)
        b_last = b[:, :, -1:, :]
        new_state = (jnp.exp(b_last[:, :, 0, :])[..., None] * state
                     + jnp.einsum('bhcd,bhce->bhde', kc * jnp.exp(b_last - b), vc))
        return new_state, o_inter + o_intra

    s0 = jnp.zeros((B, HG_HEADS, HEAD_DIM, HEAD_DIM), jnp.float32)
    _, o = lax.scan(step, s0, (heads(q), heads(k), heads(v), heads(logf)))
    return o.transpose(1, 0, 3, 2, 4).reshape(B, S, HG_HEADS, HEAD_DIM)


def swa_sink_attention(q, k, v, sinks, pos):
    B, S, _ = q.shape
    G = ATT_HEADS // ATT_KV_HEADS
    nb = S // WINDOW
    q = rope(q.reshape(B, S, ATT_HEADS, HEAD_DIM), pos)
    k = rope(k.reshape(B, S, ATT_KV_HEADS, HEAD_DIM), pos)
    v = v.reshape(B, S, ATT_KV_HEADS, HEAD_DIM)
    qb = q.reshape(B, nb, WINDOW, ATT_KV_HEADS, G, HEAD_DIM)

    def with_prev(t):
        t = t.reshape(B, nb, WINDOW, ATT_KV_HEADS, HEAD_DIM)
        prev = jnp.concatenate([jnp.zeros_like(t[:, :1]), t[:, :-1]], axis=1)
        return jnp.concatenate([prev, t], axis=2)

    kk, vv = with_prev(k), with_prev(v)
    s = jnp.einsum('bnqkgd,bnskd->bnkgqs', qb, kk).astype(jnp.float32) * (HEAD_DIM ** -0.5)
    qi = jnp.arange(WINDOW)[:, None]
    sj = jnp.arange(2 * WINDOW)[None, :]
    rel = qi + WINDOW - sj
    band = (rel >= 0) & (rel < WINDOW)
    exists = (jnp.arange(nb)[:, None, None] * WINDOW + sj[None] - WINDOW) >= 0
    mask = (band[None] & exists)[None, :, None, None]
    s = jnp.where(mask, s, MASK_VALUE)
    sink = sinks.astype(jnp.float32).reshape(1, 1, ATT_KV_HEADS, G, 1, 1)
    m = jnp.maximum(jnp.max(s, axis=-1, keepdims=True), sink)
    pr = jnp.where(mask, jnp.exp(s - m), 0.0)
    denom = jnp.sum(pr, axis=-1, keepdims=True) + jnp.exp(sink - m)
    o = jnp.einsum('bnkgqs,bnskd->bnqkgd', (pr / denom).astype(v.dtype), vv)
    return o.reshape(B, S, ATT_WIDTH)


def spatial_gating(u, v, ln_g, w_s, b_s):
    B, S, _ = u.shape
    nc = S // SG_CHUNK
    u = jax.nn.gelu(u)
    v = layernorm(jax.nn.gelu(v), ln_g)
    vg = v.reshape(B, nc, SG_CHUNK, SG_GROUPS, HEAD_DIM)
    w = w_s * jnp.tril(jnp.ones((SG_CHUNK, SG_CHUNK), w_s.dtype))
    mix = jnp.einsum('gts,bnsgd->bntgd', w, vg) + b_s.T[:, :, None]
    return (u.reshape(B, nc, SG_CHUNK, SG_GROUPS, HEAD_DIM) * mix).reshape(B, S, SG_WIDTH)


def hybrid_layer(h, p_i, pos, lb, norm_g, w_in, w_out, ffn1_gu, ffn1_down, ffn2_gu, ffn2_down,
                 hg_norm_g, sinks, sg_ln_g, sg_w, sg_b, ple_proj, ple_gate):
    B, S, _ = h.shape
    h = h + 0.5 * rmsnorm(swiglu(rmsnorm(h, norm_g[0]), ffn1_gu, ffn1_down), norm_g[1])
    z = rmsnorm(h, norm_g[2]) @ w_in
    idx = [int(c) for c in np.cumsum(IN_SPLITS)[:-1]]
    hq, hf, hi, hg, aq, ak, av, su, sv = jnp.split(z, idx, axis=-1)
    o_a = hgrn2(hq, hf, hi, lb)
    o_a = rmsnorm(o_a, hg_norm_g) * jax.nn.sigmoid(hg.astype(jnp.float32).reshape(B, S, HG_HEADS, HEAD_DIM))
    o_a = o_a.reshape(B, S, HG_WIDTH).astype(h.dtype)
    o_b = swa_sink_attention(aq, ak, av, sinks, pos).astype(h.dtype)
    o_c = spatial_gating(su, sv, sg_ln_g, sg_w, sg_b).astype(h.dtype)
    mixed = jnp.concatenate([o_a, o_b, o_c], axis=-1) @ w_out
    h = h + rmsnorm(mixed, norm_g[3])
    h = h + 0.5 * rmsnorm(swiglu(rmsnorm(h, norm_g[4]), ffn2_gu, ffn2_down), norm_g[5])
    gate = jax.nn.sigmoid(rmsnorm(h, norm_g[6]) @ ple_gate)
    h = h + rmsnorm((p_i @ ple_proj) * gate, norm_g[7])
    return h


def setup_inputs(seed: int = 0) -> dict:
    key = jax.random.key(seed)
    ks = jax.random.split(key, 20)

    def nrm(k, shape, scale):
        return jax.random.normal(k, shape, jnp.float32) * scale

    x = nrm(ks[0], (BATCH, SEQ, D_MODEL), 1.0)
    p = nrm(ks[1], (DEPTH, BATCH, SEQ, PLE_DIM), 1.0)
    positions = (jnp.arange(SEQ, dtype=jnp.int32)[None, :]
                 + jax.random.randint(ks[2], (BATCH, 1), 0, 1024, dtype=jnp.int32))
    return {
        "x": x,
        "p": p,
        "positions": positions,
        "norm_gains": 1.0 + nrm(ks[3], (DEPTH, N_NORMS, D_MODEL), 0.05),
        "w_in": nrm(ks[4], (DEPTH, D_MODEL, IN_WIDTH), D_MODEL ** -0.5),
        "w_out": nrm(ks[5], (DEPTH, MIX_WIDTH, D_MODEL), MIX_WIDTH ** -0.5),
        "ffn1_gate_up": nrm(ks[6], (DEPTH, D_MODEL, 2 * D_FF), D_MODEL ** -0.5),
        "ffn1_down": nrm(ks[7], (DEPTH, D_FF, D_MODEL), D_FF ** -0.5),
        "ffn2_gate_up": nrm(ks[8], (DEPTH, D_MODEL, 2 * D_FF), D_MODEL ** -0.5),
        "ffn2_down": nrm(ks[9], (DEPTH, D_FF, D_MODEL), D_FF ** -0.5),
        "hgrn_lb_logits": nrm(ks[10], (DEPTH, HG_WIDTH), 0.5),
        "hgrn_norm_gain": 1.0 + nrm(ks[11], (DEPTH, HEAD_DIM), 0.05),
        "attn_sinks": nrm(ks[12], (DEPTH, ATT_HEADS), 0.5),
        "sg_ln_gain": 1.0 + nrm(ks[13], (DEPTH, SG_WIDTH), 0.05),
        "sg_spatial_w": nrm(ks[14], (DEPTH, SG_GROUPS, SG_CHUNK, SG_CHUNK), SG_CHUNK ** -0.5),
        "sg_spatial_b": 1.0 + nrm(ks[15], (DEPTH, SG_GROUPS, SG_CHUNK), 0.1),
        "ple_proj": nrm(ks[16], (DEPTH, PLE_DIM, D_MODEL), PLE_DIM ** -0.5),
        "ple_gate": nrm(ks[17], (DEPTH, D_MODEL, D_MODEL), D_MODEL ** -0.5),
    }


def reference(x, p, positions, norm_gains, w_in, w_out, ffn1_gate_up, ffn1_down, ffn2_gate_up,
              ffn2_down, hgrn_lb_logits, hgrn_norm_gain, attn_sinks, sg_ln_gain, sg_spatial_w,
              sg_spatial_b, ple_proj, ple_gate):
    probs = jax.nn.softmax(hgrn_lb_logits.astype(jnp.float32), axis=0)
    lower_bounds = jnp.cumsum(probs, axis=0) - probs[0]
    h = x
    for l in range(DEPTH):
        h = hybrid_layer(h, p[l], positions, lower_bounds[l], norm_gains[l], w_in[l], w_out[l],
                         ffn1_gate_up[l], ffn1_down[l], ffn2_gate_up[l], ffn2_down[l],
                         hgrn_norm_gain[l], attn_sinks[l], sg_ln_gain[l], sg_spatial_w[l],
                         sg_spatial_b[l], ple_proj[l], ple_gate[l])
    return h
```

```cpp
#include <hip/hip_runtime.h>
#include <hip/hip_cooperative_groups.h>
#include <cstdio>
#include <cstdint>
namespace cg = cooperative_groups;
namespace pg8 {
#define PG8_LAS __attribute__((address_space(3)))
typedef unsigned short bf16_t;
typedef short bf16x8 __attribute__((ext_vector_type(8)));
typedef float f32x4 __attribute__((ext_vector_type(4)));
typedef unsigned u32x4 __attribute__((ext_vector_type(4)));
constexpr int BM = 256, BK = 64, HALF = 128, HTB = HALF * BK * 2  , STAGE_BYTES = 8 * HTB, NXCD = 8, WGM = 16;

__host__ __device__ __forceinline__ int lds_byte(int r, int c) { const int st = (r >> 4) * 2 + (c >> 5), rr = r & 15, cc = c & 31, ob = rr * 64 + cc * 2; return st * 1024 + (ob ^ (((ob >> 9) & 1) << 5)); }
__host__ __device__ __forceinline__ void stage_rc(int b, int& R, int& C) { const int st = b / 1024, sb = b % 1024, swz = sb ^ (((sb >> 9) & 1) << 5); R = (st >> 1) * 16 + swz / 64; C = (st & 1) * 32 + (swz % 64) / 2; }
__host__ __device__ __forceinline__ int perm32(int rho) { const int n = rho >> 4, i = rho & 15; return 8 * (i >> 2) + 4 * n + (i & 3); }

struct Unit { int pm, pn; };
struct Gemm { const bf16_t* A; const bf16_t* Bt; int M, N, K; };

struct StaticOrder {
    int nM, nN, nwg, G, c;
    __host__ __device__ void init(int M, int N, int G_, int c_) { nM = M / BM; nN = N / BM; nwg = nM * nN; G = G_; c = c_; }
    __host__ __device__ bool next(int i, Unit& u) const {
        const long L = (long)i * G + c; if (L >= nwg) return false;
        int wgid = (int)L; { const int q = nwg / NXCD, r = nwg % NXCD, xcd = wgid % NXCD, off = wgid / NXCD; wgid = (xcd < r ? xcd * (q + 1) : r * (q + 1) + (xcd - r) * q) + off; }
        const int nig = WGM * nN, gid = wgid / nig, fm = gid * WGM, gsz = (nM - fm) < WGM ? (nM - fm) : WGM;
        u.pm = fm + ((wgid % nig) % gsz); u.pn = (wgid % nig) / gsz; return true;
    }
    __device__ __forceinline__ void a_ready(const Unit&) const {}
    __device__ __forceinline__ void done(const Unit&) const {}
};
__device__ __forceinline__ unsigned cvt_pk_bf16(float lo, float hi) { unsigned r; asm volatile("v_cvt_pk_bf16_f32 %0, %1, %2" : "=v"(r) : "v"(lo), "v"(hi)); return r; }
typedef float f32x2 __attribute__((ext_vector_type(2)));
__device__ __forceinline__ float sigm(float x) { return __builtin_amdgcn_rcpf(1.0f + __expf(-x)); }
struct EpiPlain {
    static constexpr bool PERM = true, AFTER_DRAIN = false;
    bf16_t* O; int ldc; const float* rs;
    __device__ __forceinline__ void operator()(const f32x4 (&acc)[2][2][4][2], const Unit& u, int wr, int wc, int fr, int fq) const {
        const int row0 = u.pm * BM + wr * 64 + fr, col0 = u.pn * BM + wc * 32 + 8 * fq;
#pragma unroll
        for (int ai = 0; ai < 2; ++ai)
#pragma unroll
            for (int m = 0; m < 4; ++m) { bf16_t* rowp = O + (size_t)(row0 + ai * HALF + m * 16) * ldc + col0; const float r = rs ? rs[row0 + ai * HALF + m * 16] : 1.0f;
#pragma unroll
                for (int bj = 0; bj < 2; ++bj) { const f32x4 v0 = acc[ai][bj][m][0] * r, v1 = acc[ai][bj][m][1] * r;
                    u32x4 w; w.x = cvt_pk_bf16(v0[0], v0[1]); w.y = cvt_pk_bf16(v0[2], v0[3]); w.z = cvt_pk_bf16(v1[0], v1[1]); w.w = cvt_pk_bf16(v1[2], v1[3]);
                    *(u32x4*)(rowp + bj * HALF) = w; } }
    }
};
struct EpiSigmoid {
    static constexpr bool PERM = true, AFTER_DRAIN = false;
    bf16_t* O; int ldc;
    __device__ __forceinline__ void operator()(const f32x4 (&acc)[2][2][4][2], const Unit& u, int wr, int wc, int fr, int fq) const {
        const int row0 = u.pm * BM + wr * 64 + fr, col0 = u.pn * BM + wc * 32 + 8 * fq;
#pragma unroll
        for (int ai = 0; ai < 2; ++ai)
#pragma unroll
            for (int m = 0; m < 4; ++m) { bf16_t* rowp = O + (size_t)(row0 + ai * HALF + m * 16) * ldc + col0;
#pragma unroll
                for (int bj = 0; bj < 2; ++bj) { const f32x4 v0 = acc[ai][bj][m][0], v1 = acc[ai][bj][m][1];
                    u32x4 w; w.x = cvt_pk_bf16(sigm(v0[0]), sigm(v0[1])); w.y = cvt_pk_bf16(sigm(v0[2]), sigm(v0[3])); w.z = cvt_pk_bf16(sigm(v1[0]), sigm(v1[1])); w.w = cvt_pk_bf16(sigm(v1[2]), sigm(v1[3]));
                    *(u32x4*)(rowp + bj * HALF) = w; } }
    }
};
__device__ __forceinline__ float bflo(unsigned w) { return __uint_as_float(w << 16); }
__device__ __forceinline__ float bfhi(unsigned w) { return __uint_as_float(w & 0xffff0000u); }
struct EpiMulGate {
    static constexpr bool PERM = true, AFTER_DRAIN = false;
    bf16_t* O; const bf16_t* G; int ldc;
    __device__ __forceinline__ void operator()(const f32x4 (&acc)[2][2][4][2], const Unit& u, int wr, int wc, int fr, int fq) const {
        const int row0 = u.pm * BM + wr * 64 + fr, col0 = u.pn * BM + wc * 32 + 8 * fq;
#pragma unroll
        for (int ai = 0; ai < 2; ++ai)
#pragma unroll
            for (int m = 0; m < 4; ++m) { const size_t off = (size_t)(row0 + ai * HALF + m * 16) * ldc + col0;
#pragma unroll
                for (int bj = 0; bj < 2; ++bj) { const f32x4 v0 = acc[ai][bj][m][0], v1 = acc[ai][bj][m][1];
                    const u32x4 gv = *(const u32x4*)(G + off + bj * HALF);
                    u32x4 w; w.x = cvt_pk_bf16(v0[0] * bflo(gv.x), v0[1] * bfhi(gv.x)); w.y = cvt_pk_bf16(v0[2] * bflo(gv.y), v0[3] * bfhi(gv.y));
                    w.z = cvt_pk_bf16(v1[0] * bflo(gv.z), v1[1] * bfhi(gv.z)); w.w = cvt_pk_bf16(v1[2] * bflo(gv.w), v1[3] * bfhi(gv.w));
                    *(u32x4*)(O + off + bj * HALF) = w; }
                asm volatile("" ::: "memory"); }
    }
};
struct EpiSwiglu {
    static constexpr bool PERM = true, AFTER_DRAIN = false;
    bf16_t* O; int ldc; const float* rs;
    __device__ __forceinline__ void operator()(const f32x4 (&acc)[2][2][4][2], const Unit& u, int wr, int wc, int fr, int fq) const {
        const int row0 = u.pm * BM + wr * 64 + fr, col0 = u.pn * HALF + wc * 32 + 8 * fq;
#pragma unroll
        for (int ai = 0; ai < 2; ++ai)
#pragma unroll
            for (int m = 0; m < 4; ++m) { bf16_t* rowp = O + (size_t)(row0 + ai * HALF + m * 16) * ldc + col0; const float r = rs[row0 + ai * HALF + m * 16];
                const f32x4 g0 = acc[ai][0][m][0] * r, g1 = acc[ai][0][m][1] * r, u0 = acc[ai][1][m][0] * r, u1 = acc[ai][1][m][1] * r;
                u32x4 w; w.x = cvt_pk_bf16(g0[0] * sigm(g0[0]) * u0[0], g0[1] * sigm(g0[1]) * u0[1]); w.y = cvt_pk_bf16(g0[2] * sigm(g0[2]) * u0[2], g0[3] * sigm(g0[3]) * u0[3]);
                w.z = cvt_pk_bf16(g1[0] * sigm(g1[0]) * u1[0], g1[1] * sigm(g1[1]) * u1[1]); w.w = cvt_pk_bf16(g1[2] * sigm(g1[2]) * u1[2], g1[3] * sigm(g1[3]) * u1[3]);
                *(u32x4*)rowp = w; }
    }
};
template <class Epi, class Sched, bool ALIGN_EPI = false, bool SP2 = false>
__device__ __forceinline__ void gemm_phase(PG8_LAS unsigned char* lds, const Gemm g, const Sched& S, const Epi& E, const int tid, const int wid) {
    const int lane = tid & 63, wr = wid >> 2, wc = wid & 3, fr = lane & 15, fq = lane >> 4;
    const int K = g.K, nt = K / BK;
    unsigned voffA[2], voffB[2];
#pragma unroll
    for (int i = 0; i < 2; ++i) { int R, C; stage_rc(tid * 16 + i * 8192, R, C); const int Rb = Epi::PERM ? ((R & ~31) + perm32(R & 31)) : R;
        voffA[i] = (unsigned)(R * K + C) * 2u; voffB[i] = (unsigned)(Rb * K + C) * 2u; }
    const size_t kstep = (size_t)(BK * 2);
    const size_t hstep = (size_t)HALF * K * 2;
    const size_t tstep = 2 * hstep;
    const unsigned ldsw = (unsigned)wid * 1024u;
    const int aoff = lds_byte(wr * 64 + fr, fq * 8), boff = lds_byte(wc * 32 + fr, fq * 8);
#define PG8_SA(b, h) (((b) * 2 + (h)) * HTB)
#define PG8_SB(b, h) ((4 + (b) * 2 + (h)) * HTB)
#define PG8_STAGE(bufoff, gbase, voff) do { const unsigned long long _b = (unsigned long long)(gbase); \
        const char* _p = (const char*)(((unsigned long long)(unsigned)__builtin_amdgcn_readfirstlane((int)(unsigned)(_b >> 32)) << 32) | (unsigned)__builtin_amdgcn_readfirstlane((int)(unsigned)_b));   \
        _Pragma("unroll") for (int _i = 0; _i < 2; ++_i) \
        __builtin_amdgcn_global_load_lds((const unsigned*)(_p + (voff)[_i]), (PG8_LAS unsigned*)(lds + (bufoff) + ldsw + _i * 8192), 16, 0, 0); } while (0)
#define PG8_LDA(dst, b, h) do { _Pragma("unroll") for (int m = 0; m < 4; ++m) _Pragma("unroll") for (int k = 0; k < 2; ++k) dst[m][k] = *(const PG8_LAS bf16x8*)(lds + PG8_SA(b, h) + aoff + m * 2048 + k * 1024); } while (0)
#define PG8_LDB(dst, b, h) do { _Pragma("unroll") for (int n = 0; n < 2; ++n) _Pragma("unroll") for (int k = 0; k < 2; ++k) dst[n][k] = *(const PG8_LAS bf16x8*)(lds + PG8_SB(b, h) + boff + n * 2048 + k * 1024); } while (0)
#define PG8_MMA(ai, bj, At, Bt) do { __builtin_amdgcn_s_setprio(1); _Pragma("unroll") for (int m = 0; m < 4; ++m) _Pragma("unroll") for (int n = 0; n < 2; ++n) _Pragma("unroll") for (int k = 0; k < 2; ++k) \
        acc[ai][bj][m][n] = __builtin_amdgcn_mfma_f32_16x16x32_bf16(Bt[n][k], At[m][k], acc[ai][bj][m][n], 0, 0, 0); __builtin_amdgcn_s_setprio(0); } while (0)
#define PG8_WAIT_V(n) asm volatile("s_waitcnt vmcnt(" #n ")" ::: "memory")
#define PG8_WAIT_L(n) asm volatile("s_waitcnt lgkmcnt(" #n ")" ::: "memory")
#define PG8_BAR __builtin_amdgcn_s_barrier()
#define PG8_SCHED __builtin_amdgcn_sched_barrier(0)
    Unit cur, nxt; int ui = 0;
    if (!S.next(0, cur)) return;
    f32x4 acc[2][2][4][2];
#pragma unroll
    for (int a = 0; a < 2; ++a)
#pragma unroll
        for (int b = 0; b < 2; ++b)
#pragma unroll
            for (int m = 0; m < 4; ++m)
#pragma unroll
                for (int n = 0; n < 2; ++n) acc[a][b][m][n] = (f32x4){0.f, 0.f, 0.f, 0.f};
    bf16x8 At[4][2], B0[2][2], B1[2][2];
    const char* cA = (const char*)g.A + (size_t)cur.pm * tstep; const char* cB = (const char*)g.Bt + (size_t)cur.pn * tstep;
    S.a_ready(cur);
    if constexpr (SP2) {
        PG8_STAGE(PG8_SB(0, 0), cB, voffB); PG8_STAGE(PG8_SB(0, 1), cB + hstep, voffB); PG8_STAGE(PG8_SA(0, 0), cA, voffA); PG8_STAGE(PG8_SA(0, 1), cA + hstep, voffA);
        if (wr == 1) PG8_BAR;
        PG8_WAIT_V(2); PG8_BAR;
        PG8_STAGE(PG8_SB(1, 0), cB + kstep, voffB); PG8_STAGE(PG8_SA(1, 0), cA + kstep, voffA); PG8_STAGE(PG8_SB(1, 1), cB + hstep + kstep, voffB);
        PG8_WAIT_V(6); PG8_BAR;
    } else {
        PG8_STAGE(PG8_SB(0, 0), cB, voffB); PG8_STAGE(PG8_SA(0, 0), cA, voffA); PG8_STAGE(PG8_SB(0, 1), cB + hstep, voffB); PG8_STAGE(PG8_SA(0, 1), cA + hstep, voffA);
        if (wr == 1) PG8_BAR;
        PG8_WAIT_V(4); PG8_BAR;
        PG8_STAGE(PG8_SB(1, 0), cB + kstep, voffB); PG8_STAGE(PG8_SA(1, 0), cA + kstep, voffA); PG8_STAGE(PG8_SB(1, 1), cB + hstep + kstep, voffB);
        PG8_WAIT_V(6); PG8_BAR;
    }
    for (;;) {
        const bool has_next = S.next(ui + 1, nxt);
        const char* nA = has_next ? (const char*)g.A + (size_t)nxt.pm * tstep : cA; const char* nB = has_next ? (const char*)g.Bt + (size_t)nxt.pn * tstep : cB;
        for (int t = 0; t < nt; t += 2) {
            const bool last = (t == nt - 2);
            const char* a1 = cA + (size_t)(t + 1) * kstep;
            const char* a2 = last ? nA : cA + (size_t)(t + 2) * kstep; const char* b2 = last ? nB : cB + (size_t)(t + 2) * kstep;
            const char* a3 = a2 + kstep; const char* b3 = b2 + kstep;
            if (last && has_next) S.a_ready(nxt);
            if constexpr (SP2) {
            PG8_LDB(B0, 0, 0); PG8_LDB(B1, 0, 1); PG8_SCHED; PG8_LDA(At, 0, 0); PG8_STAGE(PG8_SA(1, 1), a1 + hstep, voffA);
            PG8_WAIT_V(8); PG8_WAIT_L(0); PG8_BAR; PG8_MMA(0, 0, At, B0); PG8_MMA(0, 1, At, B1); PG8_BAR; PG8_SCHED;
            PG8_LDA(At, 0, 1); PG8_STAGE(PG8_SB(0, 0), b2, voffB); PG8_STAGE(PG8_SB(0, 1), b2 + hstep, voffB); PG8_STAGE(PG8_SA(0, 0), a2, voffA);
            PG8_WAIT_V(8); PG8_WAIT_L(0); PG8_BAR; PG8_MMA(1, 0, At, B0); PG8_MMA(1, 1, At, B1); PG8_BAR; PG8_SCHED;
            PG8_LDB(B0, 1, 0); PG8_LDB(B1, 1, 1); PG8_SCHED; PG8_LDA(At, 1, 0); PG8_STAGE(PG8_SA(0, 1), a2 + hstep, voffA);
            PG8_WAIT_V(8); PG8_WAIT_L(0); PG8_BAR; PG8_MMA(0, 0, At, B0); PG8_MMA(0, 1, At, B1); PG8_BAR; PG8_SCHED;
            PG8_LDA(At, 1, 1); PG8_STAGE(PG8_SB(1, 0), b3, voffB); PG8_STAGE(PG8_SB(1, 1), b3 + hstep, voffB); PG8_STAGE(PG8_SA(1, 0), a3, voffA);
            PG8_WAIT_V(8); PG8_WAIT_L(0); PG8_BAR; PG8_MMA(1, 0, At, B0); PG8_MMA(1, 1, At, B1); PG8_BAR; PG8_SCHED;
            } else {
            PG8_LDB(B0, 0, 0); PG8_SCHED; PG8_LDA(At, 0, 0); PG8_STAGE(PG8_SA(1, 1), a1 + hstep, voffA);
            PG8_WAIT_L(8); PG8_BAR; PG8_WAIT_L(0); PG8_MMA(0, 0, At, B0); PG8_BAR; PG8_SCHED;
            PG8_LDB(B1, 0, 1); PG8_STAGE(PG8_SB(0, 0), b2, voffB);
            PG8_BAR; PG8_WAIT_L(0); PG8_MMA(0, 1, At, B1); PG8_BAR;
            PG8_LDA(At, 0, 1); PG8_STAGE(PG8_SA(0, 0), a2, voffA);
            PG8_BAR; PG8_WAIT_L(0); PG8_MMA(1, 0, At, B0); PG8_BAR; PG8_SCHED;
            PG8_STAGE(PG8_SB(0, 1), b2 + hstep, voffB);
            PG8_WAIT_V(6); PG8_BAR; PG8_MMA(1, 1, At, B1); PG8_BAR;
            PG8_LDB(B0, 1, 0); PG8_SCHED; PG8_LDA(At, 1, 0); PG8_STAGE(PG8_SA(0, 1), a2 + hstep, voffA);
            PG8_WAIT_L(8); PG8_BAR; PG8_WAIT_L(0); PG8_MMA(0, 0, At, B0); PG8_BAR; PG8_SCHED;
            PG8_LDB(B1, 1, 1); PG8_STAGE(PG8_SB(1, 0), b3, voffB);
            PG8_BAR; PG8_WAIT_L(0); PG8_MMA(0, 1, At, B1); PG8_BAR;
            PG8_LDA(At, 1, 1); PG8_STAGE(PG8_SA(1, 0), a3, voffA);
            PG8_BAR; PG8_WAIT_L(0); PG8_MMA(1, 0, At, B0); PG8_BAR; PG8_SCHED;
            PG8_STAGE(PG8_SB(1, 1), b3 + hstep, voffB);
            PG8_WAIT_V(6); PG8_BAR; PG8_MMA(1, 1, At, B1); PG8_BAR;
            }
        }
        if constexpr (ALIGN_EPI) { if (wr == 0) PG8_BAR; }
        if constexpr (!Epi::AFTER_DRAIN) { int l2 = __builtin_amdgcn_mbcnt_hi(~0u, __builtin_amdgcn_mbcnt_lo(~0u, 0u)); asm volatile("" : "+v"(l2)); E(acc, cur, wr, wc, l2 & 15, l2 >> 4); S.done(cur); }
        if (!has_next) break;
#pragma unroll
        for (int a = 0; a < 2; ++a)
#pragma unroll
            for (int b = 0; b < 2; ++b)
#pragma unroll
                for (int m = 0; m < 4; ++m)
#pragma unroll
                    for (int n = 0; n < 2; ++n) acc[a][b][m][n] = (f32x4){0.f, 0.f, 0.f, 0.f};
        cur = nxt; cA = nA; cB = nB; ++ui;
        if constexpr (ALIGN_EPI) { if (wr == 1) PG8_BAR; }
    }
    PG8_WAIT_V(0);
    if constexpr (!ALIGN_EPI) { if (wr == 0) PG8_BAR; }
    PG8_BAR;
    if constexpr (Epi::AFTER_DRAIN) { E.fused(acc, cur, wr, wc, fr, fq, lds, wid, lane); S.done(cur); }
#undef PG8_SA
#undef PG8_SB
#undef PG8_STAGE
#undef PG8_LDA
#undef PG8_LDB
#undef PG8_MMA
#undef PG8_WAIT_V
#undef PG8_WAIT_L
#undef PG8_BAR
#undef PG8_SCHED
}
}

constexpr int T = 32768, DM = 1024, SEQ = 4096, DFF = 2816, INW = 2304, PLE = 256;
constexpr size_t MiB = 1u << 20;
constexpr size_t WS_WL = 43 * MiB;
constexpr size_t OW_GU1 = 0, OW_D1 = 11 * MiB, OW_IN = 16 * MiB + MiB / 2, OW_OUT = 21 * MiB, OW_GU2 = 23 * MiB, OW_D2 = 34 * MiB, OW_G = 39 * MiB + MiB / 2, OW_P = 41 * MiB + MiB / 2, OW_SW = 42 * MiB;
constexpr size_t WS_COS = 86 * MiB, WS_SIN = 90 * MiB, WS_BAR = 94 * MiB, WS_RS = 94 * MiB + MiB / 4, WS_DV = 94 * MiB + MiB / 2, WS_QD = 432 * MiB, WS_SP = 448 * MiB, WS_PB = 95 * MiB, WS_XN = 128 * MiB, WS_D = 192 * MiB, WS_ACT = 256 * MiB, WS_CTL2 = WS_BAR + 16384, WS_END = 464 * MiB;
constexpr int LDS_BYTES = 147456;

typedef unsigned short bf16;
typedef short bf16x8 __attribute__((ext_vector_type(8)));
typedef float f32x4 __attribute__((ext_vector_type(4)));
typedef unsigned u32x4 __attribute__((ext_vector_type(4)));
typedef unsigned u32x2 __attribute__((ext_vector_type(2)));
#define LAS __attribute__((address_space(3)))
#define LDS_WAIT() asm volatile("s_waitcnt lgkmcnt(0)" ::: "memory")
__device__ __forceinline__ unsigned pk2(float lo, float hi) { unsigned r; asm("v_cvt_pk_bf16_f32 %0, %1, %2" : "=v"(r) : "v"(lo), "v"(hi)); return r; }
__device__ __forceinline__ unsigned f2bf(float f) { return pk2(f, 0.f) & 0xffffu; }
__device__ __forceinline__ float bf2f(unsigned short b) { return __uint_as_float(((unsigned)b) << 16); }
__device__ __forceinline__ float blo(unsigned w) { return __uint_as_float(w << 16); }
__device__ __forceinline__ float bhi(unsigned w) { return __uint_as_float(w & 0xffff0000u); }
__device__ __forceinline__ float shx(float v, int o, int lane) { return __int_as_float(__builtin_amdgcn_ds_bpermute((lane ^ o) << 2, __float_as_int(v))); }
__device__ __forceinline__ float wave_sum(float v, int lane) {
#pragma unroll
    for (int o = 1; o < 64; o <<= 1) v += shx(v, o, lane);
    return v;
}
__device__ __forceinline__ float gelu_tanh(float x) {
    const float y = 0.7978845608028654f * (x + 0.044715f * x * x * x);
    const float e = __expf(2.0f * y);
    const float th = 1.0f - 2.0f * __builtin_amdgcn_rcpf(e + 1.0f);
    return 0.5f * x * (1.0f + th);
}

struct Args { const float* x; const float* p; const int* pos; const float* ng; const float* w_in; const float* w_out; const float* gu1; const float* d1; const float* gu2; const float* d2;
              const float* lbl; const float* hgn; const float* sinks; const float* sgln; const float* sgw; const float* sgb; const float* plep; const float* pleg; float* out; unsigned char* ws; };

__device__ __forceinline__ void transpose_item(const float* W, int K, int N, bf16* WT, int k0, int n0, int drow0, float* scr, int lane, const float* gk) {
#pragma unroll
    for (int i = 0; i < 32; ++i) { const int kk = 2 * i + (lane >> 5); scr[kk * 33 + (lane & 31)] = W[(size_t)(k0 + kk) * N + n0 + (lane & 31)] * (gk ? gk[k0 + kk] : 1.0f); }
    LDS_WAIT(); asm volatile("" ::: "memory");
    const int c = lane & 7;
#pragma unroll
    for (int j = 0; j < 4; ++j) { const int n = (lane >> 3) + 8 * j; const float* s = scr + (8 * c) * 33 + n;
        u32x4 o; o.x = pk2(s[0 * 33], s[1 * 33]); o.y = pk2(s[2 * 33], s[3 * 33]); o.z = pk2(s[4 * 33], s[5 * 33]); o.w = pk2(s[6 * 33], s[7 * 33]);
        *(u32x4*)(WT + (size_t)(drow0 + n) * K + k0 + 8 * c) = o; }
    LDS_WAIT(); asm volatile("" ::: "memory");
}
__device__ __forceinline__ void transpose_plain(const float* W, int K, int N, bf16* WT, int item, float* scr, int lane, const float* gk) {
    const int nblk = N / 32, kb = item / nblk, nb = item % nblk;
    transpose_item(W, K, N, WT, 64 * kb, 32 * nb, 32 * nb, scr, lane, gk);
}
__device__ __forceinline__ void transpose_gu(const float* W, bf16* WT, int item, float* scr, int lane, const float* gk) {
    const int nblk = (2 * DFF) / 32, kb = item / nblk, nb = item % nblk, n0 = 32 * nb;
    int drow; if (n0 < DFF) { drow = 256 * (n0 / 128) + (n0 % 128); } else { const int c = n0 - DFF; drow = 256 * (c / 128) + 128 + (c % 128); }
    transpose_item(W, DM, 2 * DFF, WT, 64 * kb, n0, drow, scr, lane, gk);
}
__device__ __forceinline__ void x_row_to_bf16(const float* xrow, bf16* orow, float* rs, int lane) {
    const f32x4* xr = (const f32x4*)xrow + lane;
    float s = 0.f; u32x2* o8 = (u32x2*)orow + lane;
#pragma unroll
    for (int j = 0; j < 4; ++j) { const f32x4 v = xr[64 * j]; u32x2 w; w.x = pk2(v.x, v.y); w.y = pk2(v.z, v.w); o8[64 * j] = w;
        const float a0 = blo(w.x), a1 = bhi(w.x), a2 = blo(w.y), a3 = bhi(w.y); s += (a0 * a0 + a1 * a1) + (a2 * a2 + a3 * a3); }
    const float r = rsqrtf(wave_sum(s, lane) * (1.f / DM) + 1e-6f);
    if (lane == 0) *rs = r;
}
__device__ __forceinline__ void prologue(const Args& a, unsigned char* lds, int tid, int lane, int wave, int part, int vb, int vg, int it0, int it1) {
    unsigned char* ws = a.ws;
    float* scr = (float*)(lds + wave * 8448);
    const int gw = vb * 8 + wave, NGW = vg * 8;
    constexpr int I_GU = (DM / 64) * (2 * DFF / 32), I_D = (DFF / 64) * (DM / 32), I_IN = (DM / 64) * (INW / 32), I_SQ = (DM / 64) * (DM / 32), I_P = (PLE / 64) * (DM / 32);
    constexpr int I_LAYER = 2 * I_GU + 2 * I_D + I_IN + 2 * I_SQ + I_P;
    for (int it = it0 + gw; it < it1; it += NGW) {
        const int l = it / I_LAYER; int r = it % I_LAYER; unsigned char* wl = ws + (size_t)l * WS_WL; const float* ngl = a.ng + (size_t)l * 8 * DM;
        if (r < I_GU) { transpose_gu(a.gu1 + (size_t)l * DM * 2 * DFF, (bf16*)(wl + OW_GU1), r, scr, lane, ngl); continue; } r -= I_GU;
        if (r < I_GU) { transpose_gu(a.gu2 + (size_t)l * DM * 2 * DFF, (bf16*)(wl + OW_GU2), r, scr, lane, ngl + 4 * DM); continue; } r -= I_GU;
        if (r < I_D) { transpose_plain(a.d1 + (size_t)l * DFF * DM, DFF, DM, (bf16*)(wl + OW_D1), r, scr, lane, nullptr); continue; } r -= I_D;
        if (r < I_D) { transpose_plain(a.d2 + (size_t)l * DFF * DM, DFF, DM, (bf16*)(wl + OW_D2), r, scr, lane, nullptr); continue; } r -= I_D;
        if (r < I_IN) { transpose_plain(a.w_in + (size_t)l * DM * INW, DM, INW, (bf16*)(wl + OW_IN), r, scr, lane, ngl + 2 * DM); continue; } r -= I_IN;
        if (r < I_SQ) { transpose_plain(a.w_out + (size_t)l * DM * DM, DM, DM, (bf16*)(wl + OW_OUT), r, scr, lane, nullptr); continue; } r -= I_SQ;
        if (r < I_SQ) { transpose_plain(a.pleg + (size_t)l * DM * DM, DM, DM, (bf16*)(wl + OW_G), r, scr, lane, ngl + 6 * DM); continue; } r -= I_SQ;
        transpose_plain(a.plep + (size_t)l * PLE * DM, PLE, DM, (bf16*)(wl + OW_P), r, scr, lane, nullptr);
    }
    if (part != 0) return;
    const int gt = vb * 512 + tid, NGT = vg * 512;
    float* COS = (float*)(ws + WS_COS); float* SIN = (float*)(ws + WS_SIN);
    for (int e = gt; e < T * 32; e += NGT) {
        const int m = e >> 5, i = e & 31;
        const double inv = exp2(-(double)i * (13.287712379549449 / 32.0));
        const double ang = (double)a.pos[m] * inv;
        const double k = rint(ang * 0.15915494309189535);
        double r = fma(-k, 6.283185307179586, ang); r = fma(-k, 2.4492935982947064e-16, r);
        const float rf = (float)r;
        COS[e] = cosf(rf); SIN[e] = sinf(rf);
    }
    { const f32x4* src = (const f32x4*)a.p; u32x4* dst = (u32x4*)(ws + WS_PB);
      for (int e = gt; e < 2 * T * PLE / 8; e += NGT) { const f32x4 v0 = src[2 * e], v1 = src[2 * e + 1]; u32x4 w; w.x = pk2(v0.x, v0.y); w.y = pk2(v0.z, v0.w); w.z = pk2(v1.x, v1.y); w.w = pk2(v1.z, v1.w); dst[e] = w; } }
    for (int e = gt; e < 2 * 4 * 128 * 128; e += NGT) {
        const int l = e >> 16, r = e & 65535, t = (r >> 7) & 127, s = r & 127;
        ((bf16*)(ws + (size_t)l * WS_WL + OW_SW))[r] = (bf16)f2bf(s <= t ? a.sgw[e] : 0.f);
    }
    for (int m0 = gw; m0 < T; m0 += 4 * NGW) {
        f32x4 v[4][4]; float s[4];
#pragma unroll
        for (int r = 0; r < 4; ++r) { const f32x4* xr = (const f32x4*)(a.x + (size_t)(m0 + r * NGW) * DM) + lane;
#pragma unroll
            for (int j = 0; j < 4; ++j) v[r][j] = xr[64 * j]; }
#pragma unroll
        for (int r = 0; r < 4; ++r) { u32x2* o8 = (u32x2*)((bf16*)(ws + WS_XN) + (size_t)(m0 + r * NGW) * DM) + lane; float q = 0.f;
#pragma unroll
            for (int j = 0; j < 4; ++j) { u32x2 w; w.x = pk2(v[r][j].x, v[r][j].y); w.y = pk2(v[r][j].z, v[r][j].w); o8[64 * j] = w;
                const float a0 = blo(w.x), a1 = bhi(w.x), a2 = blo(w.y), a3 = bhi(w.y); q += (a0 * a0 + a1 * a1) + (a2 * a2 + a3 * a3); }
            s[r] = q; }
#pragma unroll
        for (int o = 1; o < 64; o <<= 1) {
#pragma unroll
            for (int r = 0; r < 4; ++r) s[r] += shx(s[r], o, lane); }
#pragma unroll
        for (int r = 0; r < 4; ++r) if (lane == 0) ((float*)(ws + WS_RS))[m0 + r * NGW] = rsqrtf(s[r] * (1.f / DM) + 1e-6f);
    }
}

__device__ __forceinline__ void unpack8(const u32x4 v, float* f) { f[0] = blo(v.x); f[1] = bhi(v.x); f[2] = blo(v.y); f[3] = bhi(v.y); f[4] = blo(v.z); f[5] = bhi(v.z); f[6] = blo(v.w); f[7] = bhi(v.w); }
__device__ __forceinline__ void norm_phase(const bf16* D, const bf16* Mul, const float* x32, bf16* HB, float* RS, float* out32, const float* ga, float scale, int lane, int wave, int vb, int vg, int r0, int nrows) {
    const int gw = vb * 8 + wave, NGW = vg * 8;
    constexpr int R = 4;
    const int RPW = nrows / NGW;
    for (int m0 = r0 + gw * RPW; m0 < r0 + (gw + 1) * RPW; m0 += R) {
        float h[R][16], d[R][16], s[R];
#pragma unroll
        for (int r = 0; r < R; ++r) { const int m = m0 + r;
            if (x32) {
#pragma unroll
                for (int j = 0; j < 2; ++j) { const f32x4* hp = (const f32x4*)(x32 + (size_t)m * DM + 512 * j + 8 * lane); const f32x4 a0 = hp[0], a1 = hp[1];
                    h[r][8 * j + 0] = a0.x; h[r][8 * j + 1] = a0.y; h[r][8 * j + 2] = a0.z; h[r][8 * j + 3] = a0.w; h[r][8 * j + 4] = a1.x; h[r][8 * j + 5] = a1.y; h[r][8 * j + 6] = a1.z; h[r][8 * j + 7] = a1.w; } }
            else {
#pragma unroll
                for (int j = 0; j < 2; ++j) unpack8(*(const u32x4*)(HB + (size_t)m * DM + 512 * j + 8 * lane), &h[r][8 * j]); }
#pragma unroll
            for (int j = 0; j < 2; ++j) unpack8(*(const u32x4*)(D + (size_t)m * DM + 512 * j + 8 * lane), &d[r][8 * j]);
            if (Mul) {
#pragma unroll
                for (int j = 0; j < 2; ++j) { float g[8]; unpack8(*(const u32x4*)(Mul + (size_t)m * DM + 512 * j + 8 * lane), g);
#pragma unroll
                    for (int i = 0; i < 8; ++i) d[r][8 * j + i] *= __builtin_amdgcn_rcpf(1.f + __expf(-g[i])); } }
        }
#pragma unroll
        for (int r = 0; r < R; ++r) { float q = 0.f;
#pragma unroll
            for (int i = 0; i < 16; ++i) q += d[r][i] * d[r][i];
            s[r] = q; }
#pragma unroll
        for (int o = 1; o < 64; o <<= 1) {
#pragma unroll
            for (int r = 0; r < R; ++r) s[r] += shx(s[r], o, lane); }
        float gg[16];
#pragma unroll
        for (int j = 0; j < 2; ++j) { const f32x4* gp = (const f32x4*)(ga + 512 * j + 8 * lane); const f32x4 a0 = gp[0], a1 = gp[1];
            gg[8 * j + 0] = a0.x; gg[8 * j + 1] = a0.y; gg[8 * j + 2] = a0.z; gg[8 * j + 3] = a0.w; gg[8 * j + 4] = a1.x; gg[8 * j + 5] = a1.y; gg[8 * j + 6] = a1.z; gg[8 * j + 7] = a1.w; }
        float s2[R];
#pragma unroll
        for (int r = 0; r < R; ++r) { const int m = m0 + r; const float rr = rsqrtf(s[r] * (1.f / DM) + 1e-6f) * scale; float q = 0.f;
#pragma unroll
            for (int i = 0; i < 16; ++i) h[r][i] += d[r][i] * rr * gg[i];
            if (out32) {
#pragma unroll
                for (int j = 0; j < 2; ++j) { f32x4* op = (f32x4*)(out32 + (size_t)m * DM + 512 * j + 8 * lane);
                    op[0] = (f32x4){h[r][8 * j + 0], h[r][8 * j + 1], h[r][8 * j + 2], h[r][8 * j + 3]}; op[1] = (f32x4){h[r][8 * j + 4], h[r][8 * j + 5], h[r][8 * j + 6], h[r][8 * j + 7]}; } }
            else {
#pragma unroll
                for (int j = 0; j < 2; ++j) { u32x4 w; w.x = pk2(h[r][8 * j + 0], h[r][8 * j + 1]); w.y = pk2(h[r][8 * j + 2], h[r][8 * j + 3]); w.z = pk2(h[r][8 * j + 4], h[r][8 * j + 5]); w.w = pk2(h[r][8 * j + 6], h[r][8 * j + 7]);
                    *(u32x4*)(HB + (size_t)m * DM + 512 * j + 8 * lane) = w; float f[8]; unpack8(w, f);
#pragma unroll
                    for (int i = 0; i < 8; ++i) q += f[i] * f[i]; } }
            s2[r] = q; }
        if (!out32) {
#pragma unroll
            for (int o = 1; o < 64; o <<= 1) {
#pragma unroll
                for (int r = 0; r < R; ++r) s2[r] += shx(s2[r], o, lane); }
#pragma unroll
            for (int r = 0; r < R; ++r) if (lane == 0) RS[m0 + r] = rsqrtf(s2[r] * (1.f / DM) + 1e-6f);
        }
    }
}

__device__ __forceinline__ void hgrn_phase(const bf16* Z, float* OA, const float* lbl, int layer, unsigned char* lds, int tid, int lane, int wave) {
    f32x4* FGQ = (f32x4*)lds;
    float* Vs = (float*)(lds + 65536);
    float* Pw = (float*)(lds + 65536 + 2048) + wave * (32 * 65);
    for (int unit = blockIdx.x; unit < 256; unit += gridDim.x) {
        const int b = unit >> 5, h = (unit >> 3) & 3, es = unit & 7, d = lane;
        float lb = 0.f; if (layer == 1) { const float l0 = lbl[h * 64 + d], l1 = lbl[256 + h * 64 + d]; lb = __builtin_amdgcn_rcpf(1.f + __expf(l0 - l1)); }
        const float oml = 1.f - lb;
        const bf16* zq = Z + (size_t)(b * SEQ) * INW + h * 64 + d;
        const bf16* zv = Z + (size_t)(b * SEQ) * INW + 512 + h * 64 + es * 8 + (tid & 7);
        unsigned short rq[4], rf[4], rv = 0;
#pragma unroll
        for (int k = 0; k < 4; ++k) { const size_t ro = (size_t)(wave + 8 * k) * INW; rq[k] = zq[ro]; rf[k] = zq[ro + 256]; }
        if (tid < 256) rv = zv[(size_t)(tid >> 3) * INW];
        float S = 0.f;
        for (int c = 0; c < 128; ++c) {
            const int buf = c & 1;
#pragma unroll
            for (int k = 0; k < 4; ++k) { const int t = wave + 8 * k; float x = bf2f(rf[k]); x = fminf(fmaxf(x, -30.f), 30.f);
                const float e = __expf(-x), rr = __builtin_amdgcn_rcpf(1.f + e); const float f = lb + oml * rr, g = oml * (e * rr);
                FGQ[(buf * 32 + t) * 64 + d] = (f32x4){f, g, bf2f(rq[k]), 0.f}; }
            if (tid < 256) Vs[buf * 256 + tid] = bf2f(rv);
            __syncthreads();
            if (c + 1 < 128) {
#pragma unroll
                for (int k = 0; k < 4; ++k) { const size_t ro = (size_t)((c + 1) * 32 + wave + 8 * k) * INW; rq[k] = zq[ro]; rf[k] = zq[ro + 256]; }
                if (tid < 256) rv = zv[(size_t)((c + 1) * 32 + (tid >> 3)) * INW];
            }
#pragma unroll
            for (int t = 0; t < 32; ++t) { const f32x4 x = FGQ[(buf * 32 + t) * 64 + lane]; const float v = Vs[buf * 256 + t * 8 + wave];
                S = fmaf(x.x, S, x.y * v); Pw[t * 65 + lane] = x.z * S; }
            const int tt = lane & 31, hf = lane >> 5; float s = 0.f;
#pragma unroll
            for (int j = 0; j < 32; ++j) s += Pw[tt * 65 + hf * 32 + j];
            s += shx(s, 32, lane);
            if (lane < 32) OA[(size_t)(b * SEQ + c * 32 + tt) * 256 + h * 64 + es * 8 + wave] = s;
        }
        __syncthreads();
    }
}

#define MFMA16(a, b, c) __builtin_amdgcn_mfma_f32_16x16x32_bf16((a), (b), (c), 0, 0, 0)
__device__ __forceinline__ bf16x8 mk8(u32x2 lo, u32x2 hi) { u32x4 w; w.x = lo.x; w.y = lo.y; w.z = hi.x; w.w = hi.y; return __builtin_bit_cast(bf16x8, w); }

__device__ __forceinline__ float bfx(const u32x4& v, int i) { const unsigned w = (i < 2) ? v.x : (i < 4) ? v.y : (i < 6) ? v.z : v.w; return (i & 1) ? bhi(w) : blo(w); }
__device__ __forceinline__ void hgrn_a(const bf16* Z, float* OA, bf16* QD, float* UB, float* DV, const float* lbl, int layer, unsigned char* lds, int lane, int wave, int vb, int vg, int c0, int nch) {
    bf16* Qs = (bf16*)lds; bf16* Kn = (bf16*)(lds + 9216); bf16* KlT = (bf16*)(lds + 18432); bf16* Vt = (bf16*)(lds + 27648);
    const int fr = lane & 15, fq = lane >> 4, t = lane;
    u32x4 nq = {0u, 0u, 0u, 0u}, nx = nq, nv = nq;
    if (c0 + vb < c0 + nch) { const int c = c0 + vb, bh = c >> 6, b = bh >> 2, h = bh & 3, n = c & 63; const bf16* zr = Z + (size_t)(b * SEQ + n * 64 + t) * INW + h * 64 + 8 * wave;
        nq = *(const u32x4*)zr; nx = *(const u32x4*)(zr + 256); nv = *(const u32x4*)(zr + 512); }
    for (int c = c0 + vb; c < c0 + nch; c += vg) {
        const int bh = c >> 6, b = bh >> 2, h = bh & 3, n = c & 63, row0 = b * SEQ + n * 64;
        const u32x4 qv = nq, xv = nx, vv = nv;
        float lf[8], kk[8];
#pragma unroll
        for (int dd = 0; dd < 8; ++dd) { float lb = 0.f; if (layer == 1) { const float l0 = lbl[h * 64 + 8 * wave + dd], l1 = lbl[256 + h * 64 + 8 * wave + dd]; lb = __builtin_amdgcn_rcpf(1.f + __expf(l0 - l1)); }
            const float oml = 1.f - lb; float x = bfx(xv, dd); x = fminf(fmaxf(x, -30.f), 30.f);
            const float e = __expf(-x), rr = __builtin_amdgcn_rcpf(1.f + e); const float f = lb + oml * rr; kk[dd] = oml * (e * rr); lf[dd] = __logf(f); }
#pragma unroll
        for (int o = 1; o < 64; o <<= 1) {
#pragma unroll
            for (int dd = 0; dd < 8; ++dd) { const float y = __int_as_float(__builtin_amdgcn_ds_bpermute(((lane - o) & 63) << 2, __float_as_int(lf[dd]))); lf[dd] += (lane >= o) ? y : 0.f; } }
        unsigned qd[8], kn[8];
#pragma unroll
        for (int dd = 0; dd < 8; ++dd) { const float bl = __int_as_float(__builtin_amdgcn_readlane(__float_as_int(lf[dd]), 63)); const float bb = lf[dd];
            qd[dd] = f2bf(bfx(qv, dd) * __expf(bb)); kn[dd] = f2bf(kk[dd] * __expf(fminf(-bb, 80.f)));
            KlT[(8 * wave + dd) * 72 + t] = (bf16)f2bf(kk[dd] * __expf(bl - bb));
            Vt[(8 * wave + dd) * 72 + t] = (bf16)((dd & 1) ? ((dd < 2 ? vv.x : dd < 4 ? vv.y : dd < 6 ? vv.z : vv.w) >> 16) : ((dd < 2 ? vv.x : dd < 4 ? vv.y : dd < 6 ? vv.z : vv.w) & 0xffffu));
            if (lane == 63) DV[c * 64 + 8 * wave + dd] = __expf(bb); }
        { u32x4 w; w.x = qd[0] | (qd[1] << 16); w.y = qd[2] | (qd[3] << 16); w.z = qd[4] | (qd[5] << 16); w.w = qd[6] | (qd[7] << 16);
          *(u32x4*)(Qs + t * 72 + 8 * wave) = w; *(u32x4*)(QD + (size_t)(row0 + t) * 256 + h * 64 + 8 * wave) = w;
          u32x4 k2; k2.x = kn[0] | (kn[1] << 16); k2.y = kn[2] | (kn[3] << 16); k2.z = kn[4] | (kn[5] << 16); k2.w = kn[6] | (kn[7] << 16);
          *(u32x4*)(Kn + t * 72 + 8 * wave) = k2; }
        __syncthreads();
        if (c + vg < c0 + nch) { const int c2 = c + vg, bh2 = c2 >> 6, b2 = bh2 >> 2, h2 = bh2 & 3, n2 = c2 & 63; const bf16* zr = Z + (size_t)(b2 * SEQ + n2 * 64 + t) * INW + h2 * 64 + 8 * wave;
            nq = *(const u32x4*)zr; nx = *(const u32x4*)(zr + 256); nv = *(const u32x4*)(zr + 512); }
        const int it = wave & 3, eh = wave >> 2;
        bf16x8 qf[2];
#pragma unroll
        for (int ks = 0; ks < 2; ++ks) qf[ks] = *(const bf16x8*)(Qs + (16 * it + fr) * 72 + 32 * ks + 8 * fq);
        f32x4 aa[4];
#pragma unroll
        for (int jt = 0; jt < 4; ++jt) { f32x4 acc = {0.f, 0.f, 0.f, 0.f};
            if (jt <= it) {
#pragma unroll
                for (int ks = 0; ks < 2; ++ks) { const bf16x8 kf = *(const bf16x8*)(Kn + (16 * jt + fr) * 72 + 32 * ks + 8 * fq); acc = MFMA16(kf, qf[ks], acc); }
#pragma unroll
                for (int r = 0; r < 4; ++r) acc[r] = (16 * jt + 4 * fq + r <= 16 * it + fr) ? acc[r] : 0.f; }
            aa[jt] = acc; }
#pragma unroll
        for (int ee = 0; ee < 2; ++ee) { const int et = 2 * eh + ee; f32x4 o = {0.f, 0.f, 0.f, 0.f};
#pragma unroll
            for (int k2 = 0; k2 < 2; ++k2) { u32x4 pw; pw.x = pk2(aa[2 * k2][0], aa[2 * k2][1]); pw.y = pk2(aa[2 * k2][2], aa[2 * k2][3]); pw.z = pk2(aa[2 * k2 + 1][0], aa[2 * k2 + 1][1]); pw.w = pk2(aa[2 * k2 + 1][2], aa[2 * k2 + 1][3]);
                const bf16* vrow = Vt + (16 * et + fr) * 72; const u32x2 lo = *(const u32x2*)(vrow + 32 * k2 + 4 * fq), hi = *(const u32x2*)(vrow + 32 * k2 + 16 + 4 * fq);
                o = MFMA16(mk8(lo, hi), __builtin_bit_cast(bf16x8, pw), o); }
            *(f32x4*)(OA + (size_t)(row0 + 16 * it + fr) * 256 + h * 64 + 16 * et + 4 * fq) = o; }
#pragma unroll
        for (int ee = 0; ee < 2; ++ee) { const int et = 2 * eh + ee, dt = it; f32x4 u = {0.f, 0.f, 0.f, 0.f};
#pragma unroll
            for (int ks = 0; ks < 2; ++ks) { const bf16x8 xf = *(const bf16x8*)(KlT + (16 * dt + fr) * 72 + 32 * ks + 8 * fq); const bf16x8 yf = *(const bf16x8*)(Vt + (16 * et + fr) * 72 + 32 * ks + 8 * fq); u = MFMA16(xf, yf, u); }
            *(f32x4*)(UB + (size_t)c * 4096 + (16 * et + fr) * 64 + 16 * dt + 4 * fq) = u; }
        __syncthreads();
    }
}
__device__ __forceinline__ void hgrn_b(const float* __restrict__ UB, const float* __restrict__ DV, bf16* __restrict__ SP, int tid, int vb, int vg, int bh0, int nbh) {
    for (int gid = vb * 512 + tid; gid < nbh * 4096; gid += vg * 512) {
        const int bh = bh0 + (gid >> 12), ed = gid & 4095, d = ed & 63; float S = 0.f;
#pragma unroll 8
        for (int n = 0; n < 64; ++n) { const int c = bh * 64 + n; SP[(size_t)c * 4096 + ed] = (bf16)f2bf(S); S = DV[c * 64 + d] * S + UB[(size_t)c * 4096 + ed]; }
    }
}
__device__ __forceinline__ void hgrn_c(const bf16* SP, const bf16* QD, const float* OA, const bf16* Z, bf16* MX, const float* hgn, int lane, int wave, int vb, int vg, int c0, int nch) {
    const int gw = vb * 8 + wave, NGW = vg * 8, fr = lane & 15, fq = lane >> 4;
    for (int wt = gw; wt < 4 * nch; wt += NGW) {
        const int c = c0 + (wt >> 2), it = wt & 3, bh = c >> 6, b = bh >> 2, h = bh & 3, n = c & 63, row = b * SEQ + n * 64 + 16 * it + fr;
        f32x4 o[4];
#pragma unroll
        for (int et = 0; et < 4; ++et) o[et] = *(const f32x4*)(OA + (size_t)row * 256 + h * 64 + 16 * et + 4 * fq);
#pragma unroll
        for (int ks = 0; ks < 2; ++ks) { const bf16x8 qf = *(const bf16x8*)(QD + (size_t)row * 256 + h * 64 + 32 * ks + 8 * fq);
#pragma unroll
            for (int et = 0; et < 4; ++et) { const bf16x8 sf = *(const bf16x8*)(SP + (size_t)c * 4096 + (16 * et + fr) * 64 + 32 * ks + 8 * fq); o[et] = MFMA16(sf, qf, o[et]); } }
        float ss = 0.f;
#pragma unroll
        for (int et = 0; et < 4; ++et) ss += (o[et][0] * o[et][0] + o[et][1] * o[et][1]) + (o[et][2] * o[et][2] + o[et][3] * o[et][3]);
        ss += shx(ss, 16, lane); ss += shx(ss, 32, lane);
        const float r = rsqrtf(ss * (1.f / 64.f) + 1e-6f);
#pragma unroll
        for (int et = 0; et < 4; ++et) { const int e0 = 16 * et + 4 * fq; const f32x4 gain = *(const f32x4*)(hgn + e0);
            const u32x2 gv = *(const u32x2*)(Z + (size_t)row * INW + 768 + h * 64 + e0);
            const float g0 = __builtin_amdgcn_rcpf(1.f + __expf(-blo(gv.x))), g1 = __builtin_amdgcn_rcpf(1.f + __expf(-bhi(gv.x))), g2 = __builtin_amdgcn_rcpf(1.f + __expf(-blo(gv.y))), g3 = __builtin_amdgcn_rcpf(1.f + __expf(-bhi(gv.y)));
            u32x2 w; w.x = pk2(o[et][0] * r * gain.x * g0, o[et][1] * r * gain.y * g1); w.y = pk2(o[et][2] * r * gain.z * g2, o[et][3] * r * gain.w * g3);
            *(u32x2*)(MX + (size_t)row * DM + h * 64 + e0) = w; }
    }
}
__device__ __forceinline__ void attn_unit(const bf16* Z, bf16* MX, const float* COS, const float* SIN, const float* sinks, int unit, unsigned char* lds, int tid, int lane, int wave) {
    bf16* Ks = (bf16*)lds;
    bf16* Vt = (bf16*)(lds + 36864);
    bf16* Qs4 = (bf16*)(lds + 36864 + 33792);
    asm volatile("" : "+v"(tid)); lane = tid & 63;
    const int b = unit >> 6, n = (unit >> 1) & 31, kv = unit & 1, fr = lane & 15, fq = lane >> 4;
    const int tok0 = b * SEQ + n * 128 - 128;
#pragma unroll
    for (int k = 0; k < 2; ++k) { const int idx = tid + 512 * k, sj = idx >> 2, g = idx & 3, row = tok0 + sj;
        u32x4 o1 = {0u, 0u, 0u, 0u}, o2 = {0u, 0u, 0u, 0u};
        if (n > 0 || sj >= 128) { const bf16* zr = Z + (size_t)row * INW + 1536 + kv * 64 + 8 * g; const u32x4 xa = *(const u32x4*)zr, xb = *(const u32x4*)(zr + 32);
            const f32x4* cp = (const f32x4*)(COS + row * 32 + 8 * g); const f32x4* sp = (const f32x4*)(SIN + row * 32 + 8 * g); const f32x4 c0 = cp[0], c1 = cp[1], s0 = sp[0], s1 = sp[1];
            float x1[8], x2[8]; unpack8(xa, x1); unpack8(xb, x2);
            const float cc[8] = {c0.x, c0.y, c0.z, c0.w, c1.x, c1.y, c1.z, c1.w}, ss[8] = {s0.x, s0.y, s0.z, s0.w, s1.x, s1.y, s1.z, s1.w};
            float r1[8], r2[8];
#pragma unroll
            for (int i = 0; i < 8; ++i) { r1[i] = x1[i] * cc[i] - x2[i] * ss[i]; r2[i] = x2[i] * cc[i] + x1[i] * ss[i]; }
            o1.x = pk2(r1[0], r1[1]); o1.y = pk2(r1[2], r1[3]); o1.z = pk2(r1[4], r1[5]); o1.w = pk2(r1[6], r1[7]);
            o2.x = pk2(r2[0], r2[1]); o2.y = pk2(r2[2], r2[3]); o2.z = pk2(r2[4], r2[5]); o2.w = pk2(r2[6], r2[7]); }
        *(u32x4*)(Ks + sj * 72 + 8 * g) = o1; *(u32x4*)(Ks + sj * 72 + 32 + 8 * g) = o2; }
#pragma unroll
    for (int k = 0; k < 4; ++k) { const int idx = tid + 512 * k, sj = idx & 255, g8 = idx >> 8, row = tok0 + sj;
        u32x4 v = {0u, 0u, 0u, 0u};
        if (n > 0 || sj >= 128) v = *(const u32x4*)(Z + (size_t)row * INW + 1664 + kv * 64 + 8 * g8);
        bf16* vp = Vt + (8 * g8) * 264 + sj;
        vp[0 * 264] = (bf16)(v.x & 0xffffu); vp[1 * 264] = (bf16)(v.x >> 16); vp[2 * 264] = (bf16)(v.y & 0xffffu); vp[3 * 264] = (bf16)(v.y >> 16);
        vp[4 * 264] = (bf16)(v.z & 0xffffu); vp[5 * 264] = (bf16)(v.z >> 16); vp[6 * 264] = (bf16)(v.w & 0xffffu); vp[7 * 264] = (bf16)(v.w >> 16); }
    { const int qi = tid >> 2, g = tid & 3, row = b * SEQ + n * 128 + qi;
      const f32x4* cp = (const f32x4*)(COS + row * 32 + 8 * g); const f32x4* sp = (const f32x4*)(SIN + row * 32 + 8 * g); const f32x4 c0 = cp[0], c1 = cp[1], s0 = sp[0], s1 = sp[1];
      const float cc[8] = {c0.x, c0.y, c0.z, c0.w, c1.x, c1.y, c1.z, c1.w}, ss[8] = {s0.x, s0.y, s0.z, s0.w, s1.x, s1.y, s1.z, s1.w};
#pragma unroll
      for (int hh = 0; hh < 4; ++hh) { const bf16* zr = Z + (size_t)row * INW + 1024 + (kv * 4 + hh) * 64 + 8 * g; const u32x4 xa = *(const u32x4*)zr, xb = *(const u32x4*)(zr + 32);
          float x1[8], x2[8]; unpack8(xa, x1); unpack8(xb, x2); float r1[8], r2[8];
#pragma unroll
          for (int i = 0; i < 8; ++i) { r1[i] = (x1[i] * cc[i] - x2[i] * ss[i]) * 0.125f; r2[i] = (x2[i] * cc[i] + x1[i] * ss[i]) * 0.125f; }
          u32x4 o1, o2; o1.x = pk2(r1[0], r1[1]); o1.y = pk2(r1[2], r1[3]); o1.z = pk2(r1[4], r1[5]); o1.w = pk2(r1[6], r1[7]);
          o2.x = pk2(r2[0], r2[1]); o2.y = pk2(r2[2], r2[3]); o2.z = pk2(r2[4], r2[5]); o2.w = pk2(r2[6], r2[7]);
          *(u32x4*)(Qs4 + hh * 9216 + qi * 72 + 8 * g) = o1; *(u32x4*)(Qs4 + hh * 9216 + qi * 72 + 32 + 8 * g) = o2; } }
    __syncthreads();
    for (int g = 0; g < 4; ++g) {
        const int hq = kv * 4 + g; const bf16* Qs = Qs4 + g * 9216;
        bf16x8 qf[2];
#pragma unroll
        for (int ks = 0; ks < 2; ++ks) qf[ks] = *(const bf16x8*)(Qs + (16 * wave + fr) * 72 + 32 * ks + 8 * fq);
        f32x4 sacc[9];
#pragma unroll
        for (int j = 0; j < 9; ++j) { f32x4 acc = {0.f, 0.f, 0.f, 0.f};
#pragma unroll
            for (int ks = 0; ks < 2; ++ks) { const bf16x8 kf = *(const bf16x8*)(Ks + (16 * (wave + j) + fr) * 72 + 32 * ks + 8 * fq); acc = MFMA16(kf, qf[ks], acc); }
            sacc[j] = acc; }
        const int qi = 16 * wave + fr; const float sink = sinks[hq];
        float mx = -1e30f;
#pragma unroll
        for (int j = 0; j < 9; ++j) { const float penu = (n > 0 || wave + j >= 8) ? 0.f : -1e30f;
#pragma unroll
            for (int r = 0; r < 4; ++r) { float pen = penu; const int delta = 16 * j + 4 * fq + r - fr;
                if (j == 0) pen = (delta > 0) ? pen : -1e30f;
                if (j == 8) pen = (delta <= 128) ? pen : -1e30f;
                const float s = sacc[j][r] + pen; sacc[j][r] = s; mx = fmaxf(mx, s); } }
        mx = fmaxf(mx, shx(mx, 16, lane)); mx = fmaxf(mx, shx(mx, 32, lane)); mx = fmaxf(mx, sink);
        float sum = 0.f;
#pragma unroll
        for (int j = 0; j < 9; ++j)
#pragma unroll
            for (int r = 0; r < 4; ++r) { const float p = __expf(sacc[j][r] - mx); sacc[j][r] = p; sum += p; }
        sum += shx(sum, 16, lane); sum += shx(sum, 32, lane);
        const float inv = 1.f / (sum + __expf(sink - mx));
        f32x4 o[4];
#pragma unroll
        for (int dt = 0; dt < 4; ++dt) o[dt] = (f32x4){0.f, 0.f, 0.f, 0.f};
#pragma unroll
        for (int kk = 0; kk < 5; ++kk) { const int j0 = 2 * kk, j1 = 2 * kk + 1;
            u32x4 pw; pw.x = pk2(sacc[j0][0], sacc[j0][1]); pw.y = pk2(sacc[j0][2], sacc[j0][3]);
            if (j1 < 9) { pw.z = pk2(sacc[j1 < 9 ? j1 : 8][0], sacc[j1 < 9 ? j1 : 8][1]); pw.w = pk2(sacc[j1 < 9 ? j1 : 8][2], sacc[j1 < 9 ? j1 : 8][3]); } else { pw.z = 0u; pw.w = 0u; }
            const bf16x8 pf = __builtin_bit_cast(bf16x8, pw);
            const int key0 = 16 * (wave + j0) + 4 * fq, key1 = (j1 < 9) ? 16 * (wave + j1) + 4 * fq : key0;
#pragma unroll
            for (int dt = 0; dt < 4; ++dt) { const bf16* vrow = Vt + (16 * dt + fr) * 264; const u32x2 lo = *(const u32x2*)(vrow + key0), hi = *(const u32x2*)(vrow + key1);
                o[dt] = MFMA16(mk8(lo, hi), pf, o[dt]); } }
        bf16* orow = MX + (size_t)(b * SEQ + n * 128 + qi) * DM + 256 + hq * 64 + 4 * fq;
#pragma unroll
        for (int dt = 0; dt < 4; ++dt) { u32x2 w; w.x = pk2(o[dt][0] * inv, o[dt][1] * inv); w.y = pk2(o[dt][2] * inv, o[dt][3] * inv); *(u32x2*)(orow + 16 * dt) = w; }
    }
    __syncthreads();
}
__device__ __forceinline__ void sgu_unit(const bf16* Z, bf16* MX, const bf16* SW, const float* lng, const float* sgb, int unit, unsigned char* lds, int tid, int lane, int wave) {
    bf16* Vt = (bf16*)lds;
    const int b = unit >> 5, nc = unit & 31, row0 = b * SEQ + nc * 128, fr = lane & 15, fq = lane >> 4;
#pragma unroll 4
    for (int k = 0; k < 16; ++k) { const int t = wave + 8 * k; const bf16* zr = Z + (size_t)(row0 + t) * INW + 2048;
        float x[4]; float s = 0.f;
#pragma unroll
        for (int i = 0; i < 4; ++i) { x[i] = gelu_tanh(bf2f(zr[lane + 64 * i])); s += x[i]; }
        const float mu = wave_sum(s, lane) * (1.f / 256.f); float q = 0.f;
#pragma unroll
        for (int i = 0; i < 4; ++i) { x[i] -= mu; q += x[i] * x[i]; }
        const float rstd = rsqrtf(wave_sum(q, lane) * (1.f / 256.f) + 1e-6f);
#pragma unroll
        for (int i = 0; i < 4; ++i) { const int c = lane + 64 * i; Vt[c * 132 + t] = (bf16)f2bf(x[i] * rstd * lng[c]); } }
    __syncthreads();
    const int nks = (wave >> 1) + 1, t = 16 * wave + fr;
    for (int g = 0; g < 4; ++g) {
        f32x4 acc[4];
#pragma unroll
        for (int dt = 0; dt < 4; ++dt) acc[dt] = (f32x4){0.f, 0.f, 0.f, 0.f};
        for (int ks = 0; ks < nks; ++ks) {
            const bf16x8 wf = *(const bf16x8*)(SW + (size_t)(g * 128 + t) * 128 + 32 * ks + 8 * fq);
#pragma unroll
            for (int dt = 0; dt < 4; ++dt) { const bf16* vrow = Vt + (g * 64 + 16 * dt + fr) * 132 + 32 * ks + 8 * fq; const u32x2 lo = *(const u32x2*)vrow, hi = *(const u32x2*)(vrow + 4);
                acc[dt] = MFMA16(mk8(lo, hi), wf, acc[dt]); } }
        const float bias = sgb[g * 128 + t];
        const bf16* urow = Z + (size_t)(row0 + t) * INW + 1792 + g * 64 + 4 * fq; bf16* orow = MX + (size_t)(row0 + t) * DM + 768 + g * 64 + 4 * fq;
#pragma unroll
        for (int dt = 0; dt < 4; ++dt) { const u32x2 uv = *(const u32x2*)(urow + 16 * dt);
            u32x2 w; w.x = pk2(gelu_tanh(blo(uv.x)) * (acc[dt][0] + bias), gelu_tanh(bhi(uv.x)) * (acc[dt][1] + bias)); w.y = pk2(gelu_tanh(blo(uv.y)) * (acc[dt][2] + bias), gelu_tanh(bhi(uv.y)) * (acc[dt][3] + bias));
            *(u32x2*)(orow + 16 * dt) = w; }
    }
    __syncthreads();
}
__device__ __forceinline__ void hgrn_epilogue(const float* OA, const bf16* Z, bf16* MX, const float* hgn, int lane, int wave) {
    const int gw = blockIdx.x * 8 + wave, NGW = gridDim.x * 8;
    const f32x4 gain = ((const f32x4*)hgn)[lane & 15];
    for (int m = gw; m < T; m += NGW) {
        const f32x4 o = ((const f32x4*)(OA + (size_t)m * 256))[lane];
        float ss = (o.x * o.x + o.y * o.y) + (o.z * o.z + o.w * o.w);
        ss += shx(ss, 1, lane); ss += shx(ss, 2, lane); ss += shx(ss, 4, lane); ss += shx(ss, 8, lane);
        const float r = rsqrtf(ss * (1.f / 64.f) + 1e-6f);
        const u32x2 gv = *(const u32x2*)(Z + (size_t)m * INW + 768 + 4 * lane);
        const float g0 = __builtin_amdgcn_rcpf(1.f + __expf(-blo(gv.x))), g1 = __builtin_amdgcn_rcpf(1.f + __expf(-bhi(gv.x))), g2 = __builtin_amdgcn_rcpf(1.f + __expf(-blo(gv.y))), g3 = __builtin_amdgcn_rcpf(1.f + __expf(-bhi(gv.y)));
        u32x2 w; w.x = pk2(o.x * r * gain.x * g0, o.y * r * gain.y * g1); w.y = pk2(o.z * r * gain.z * g2, o.w * r * gain.w * g3);
        *(u32x2*)(MX + (size_t)m * DM + 4 * lane) = w;
    }
}

#define RLX_AGENT __ATOMIC_RELAXED, __HIP_MEMORY_SCOPE_AGENT
#define XB_TMO      128
#define XB_XCNT(j)  (256  + 64 * (j))
#define XB_XSUB(j)  (1280 + 64 * (j))
#define XB_XGEN(j)  (2304 + 64 * (j))
#define XB_TOP      3328
#define XB_TOPGEN   3392
#define XCD_BAR_WORDS 3456
#define XB_SPIN_CAP (1u << 18)

__device__ __forceinline__ unsigned xb_ld(unsigned* p)              { return __hip_atomic_load(p, __ATOMIC_RELAXED, __HIP_MEMORY_SCOPE_AGENT); }
__device__ __forceinline__ unsigned xb_add(unsigned* p, unsigned v) { return __hip_atomic_fetch_add(p, v, __ATOMIC_RELAXED, __HIP_MEMORY_SCOPE_AGENT); }
__device__ __forceinline__ unsigned xb_xcc_id() { return (unsigned)__builtin_amdgcn_s_getreg((3 << 11) | 20) & 0xFu; }
#define XB_SPIN(cond, bar) do { unsigned _sp = 0; while (cond) { __builtin_amdgcn_s_sleep(1); \
    if ((++_sp & 255u) == 0u) { if (xb_ld(&(bar)[XB_TMO])) break; if (_sp > XB_SPIN_CAP) { atomicAdd(&(bar)[XB_TMO], 1u); break; } } } } while (0)

struct XcdBarrier {
    unsigned ng;
    unsigned* bar; unsigned x;
    volatile LAS unsigned* st;
};

__device__ __forceinline__ XcdBarrier xcd_barrier_post(unsigned* bar, volatile LAS unsigned* st) {
    XcdBarrier b; b.ng = 0u; b.bar = bar; b.x = xb_xcc_id(); b.st = st;
    if (threadIdx.x == 0) (void)xb_add(&bar[XB_XCNT(b.x)], 1u);
    return b;
}
__device__ __forceinline__ void xcd_barrier_complete(unsigned* bar, unsigned x, unsigned& nloc, unsigned& nx, unsigned G) {
    unsigned sum, cnt, mine, sp = 0u;
    for (;;) {
        sum = 0u; cnt = 0u; mine = 0u;
#pragma unroll
        for (unsigned j = 0; j < 16; ++j) { const unsigned c = xb_ld(&bar[XB_XCNT(j)]); sum += c; cnt += (c > 0u) ? 1u : 0u; mine = (j == x) ? c : mine; }
        if (sum == G) break;
        __builtin_amdgcn_s_sleep(1);
        if ((++sp & 255u) == 0u) { if (xb_ld(&bar[XB_TMO])) break; if (sp > XB_SPIN_CAP) { atomicAdd(&bar[XB_TMO], 1u); break; } }
    }
    nloc = mine > 0u ? mine : 1u; nx = cnt > 0u ? cnt : 1u;
}

__device__ __forceinline__ void xcd_barrier(const XcdBarrier& b) {
    asm volatile("s_waitcnt vmcnt(0)" ::: "memory");
    __syncthreads();
    if (threadIdx.x == 0) {
        unsigned* bar = b.bar;
        __builtin_amdgcn_s_waitcnt(0);
        unsigned nloc = b.st[0], nx = b.st[1];
        if (nloc == 0u) { xcd_barrier_complete(bar, b.x, nloc, nx, b.ng); b.st[0] = nloc; b.st[1] = nx; }
        const unsigned old = xb_add(&bar[XB_XSUB(b.x)], 1u);
        const unsigned gen = old / nloc;
        if (old + 1u == (gen + 1u) * nloc) {
            if (!(nx == 1u && nloc == b.ng)) {
            __builtin_amdgcn_fence(__ATOMIC_RELEASE, "agent");
            }
            asm volatile("s_waitcnt vmcnt(0)" ::: "memory");
            if (nx != 1u) {
            const unsigned og = xb_add(&bar[XB_TOP], 1u);
            const unsigned tg = og / nx;
            if (og + 1u == (tg + 1u) * nx) xb_add(&bar[XB_TOPGEN], 1u);
            else XB_SPIN(xb_ld(&bar[XB_TOPGEN]) == tg, bar);
            }
            __builtin_amdgcn_fence(__ATOMIC_ACQUIRE, "agent");
            xb_add(&bar[XB_XGEN(b.x)], 1u);
            asm volatile("s_waitcnt vmcnt(0)" ::: "memory");
        } else {
            XB_SPIN(xb_ld(&bar[XB_XGEN(b.x)]) == gen, bar);
            __builtin_amdgcn_fence(__ATOMIC_ACQUIRE, "agent");
            asm volatile("s_waitcnt vmcnt(0)" ::: "memory");
        }
    }
    __syncthreads();
}


__global__ void __launch_bounds__(512) hybrid_fwd(Args a0) {
    extern __shared__ __attribute__((aligned(16))) unsigned char lds[];
    cg::grid_group grid = cg::this_grid();
    PG8_LAS unsigned char* glds = (PG8_LAS unsigned char*)lds;
    const int wave0 = __builtin_amdgcn_readfirstlane(threadIdx.x >> 6);
    volatile LAS unsigned* bst = (volatile LAS unsigned*)((LAS unsigned char*)lds + (LDS_BYTES - 64));
    if (threadIdx.x < 4) bst[threadIdx.x] = 0u;
    __syncthreads();
    const int grp = blockIdx.x & 7, vb = blockIdx.x >> 3, vg = gridDim.x >> 3;
    const unsigned bx_ = xcd_barrier_post((unsigned*)(a0.ws + WS_BAR), bst).x;
    (void)xcd_barrier_post((unsigned*)(a0.ws + WS_CTL2) + 4096 * grp, bst + 2);
    { const int tid = threadIdx.x, lane = tid & 63;
      prologue(a0, lds, tid, lane, wave0, 0, (int)blockIdx.x, (int)gridDim.x, 0, 10752); }
    { XcdBarrier bb; bb.ng = gridDim.x; bb.bar = (unsigned*)(a0.ws + WS_BAR); bb.x = bx_; bb.st = bst; xcd_barrier(bb); }
    if (a0.ws == nullptr) grid.sync();
    { const int tid = threadIdx.x, lane = tid & 63; prologue(a0, lds, tid, lane, wave0, 1, vb, vg, 10752 + 192 * grp * (grp - 1), 10752 + 192 * grp * (grp + 1)); }
    asm volatile("s_waitcnt vmcnt(0)" ::: "memory"); __syncthreads();
    if (threadIdx.x == 0) { __builtin_amdgcn_fence(__ATOMIC_RELEASE, "agent"); asm volatile("s_waitcnt vmcnt(0)" ::: "memory");
        __hip_atomic_fetch_add((unsigned*)(a0.ws + WS_CTL2) + 8 * 4096, 1u, __ATOMIC_RELAXED, __HIP_MEMORY_SCOPE_AGENT); }
    const int r0 = grp * (T / 8);

    for (int st = 0; st < 28; ++st) {
        const int l = st / 14, s = st % 14;
        int olane = __builtin_amdgcn_mbcnt_hi(~0u, __builtin_amdgcn_mbcnt_lo(~0u, 0u)); asm volatile("" : "+v"(olane));
        const int otid = wave0 * 64 + olane;
        unsigned long long kpi = (unsigned long long)__builtin_amdgcn_kernarg_segment_ptr(); asm volatile("" : "+s"(kpi));
        const __attribute__((address_space(4))) Args& a = *(const __attribute__((address_space(4))) Args*)kpi;
        unsigned char* ws = a.ws;
        const int tid = otid, lane = olane, wave = wave0;
        if (st == 14) {
            if (tid == 0) { unsigned sp = 0; while (__hip_atomic_load((unsigned*)(ws + WS_CTL2) + 8 * 4096, __ATOMIC_RELAXED, __HIP_MEMORY_SCOPE_AGENT) < gridDim.x && ++sp < (1u << 22)) __builtin_amdgcn_s_sleep(2);
                __builtin_amdgcn_fence(__ATOMIC_ACQUIRE, "agent"); asm volatile("s_waitcnt vmcnt(0)" ::: "memory"); }
            __syncthreads();
        }
        const size_t rg = (size_t)grp * (T / 8), cg0 = (size_t)grp * 256;
        bf16* XN = (bf16*)(ws + WS_XN);
        bf16* MX = (bf16*)((unsigned char*)a.out + (size_t)grp * 16 * MiB) - rg * DM;
        float* RS = (float*)(ws + WS_RS);
        unsigned char* dreg = ws + WS_D + (size_t)grp * 8 * MiB;
        bf16* Dd = (bf16*)dreg - rg * DM; float* OA = (float*)dreg - rg * 256; float* UBv = (float*)(dreg + 4 * MiB) - cg0 * 4096;
        unsigned char* areg = ws + WS_ACT + (size_t)grp * 22 * MiB;
        bf16* ACT = (bf16*)areg - rg * DFF; bf16* Z = (bf16*)areg - rg * INW; bf16* SG = (bf16*)areg - rg * DM;
        const float* COS = (const float*)(ws + WS_COS); const float* SIN = (const float*)(ws + WS_SIN);
        unsigned char* wl = ws + (size_t)l * WS_WL;
        const float* ng = a.ng + (size_t)l * 8 * DM;
        const size_t ro = (size_t)r0;
        if (s == 0 || s == 9) {
            pg8::Gemm g{XN + ro * DM, (const bf16*)(wl + (s == 0 ? OW_GU1 : OW_GU2)), T / 8, 2 * DFF, DM}; pg8::StaticOrder S; S.init(T / 8, 2 * DFF, vg, vb);
            pg8::EpiSwiglu E{ACT + ro * DFF, DFF, RS + ro};
            pg8::gemm_phase<pg8::EpiSwiglu, pg8::StaticOrder, true, true>(glds, g, S, E, otid, wave0);
        } else if (s == 1 || s == 10 || s == 3 || s == 7) {
            const int N = (s == 3) ? INW : DM, K = (s == 1 || s == 10) ? DFF : DM;
            const bf16* A = ((s == 3) ? XN : (s == 7 ? MX : ACT)) + ro * K;
            const bf16* B = (const bf16*)(wl + (s == 1 ? OW_D1 : s == 10 ? OW_D2 : s == 3 ? OW_IN : OW_OUT));
            pg8::Gemm g{A, B, T / 8, N, K}; pg8::StaticOrder S; S.init(T / 8, N, vg, vb);
            pg8::EpiPlain E{((s == 3) ? Z : Dd) + ro * N, N, (s == 3) ? RS + ro : nullptr};
            pg8::gemm_phase<pg8::EpiPlain, pg8::StaticOrder, true, true>(glds, g, S, E, otid, wave0);
        } else if (s == 2 || s == 8 || s == 11 || s == 13) {
            const int ia = (s == 2) ? 1 : (s == 8) ? 3 : (s == 11) ? 5 : 7;
            const float* ga = ng + ia * DM;
            const float scale = (s == 2 || s == 11) ? 0.5f : 1.0f;
            norm_phase(Dd, (s == 13) ? SG : nullptr, (st == 2) ? a.x : nullptr, XN, RS, (st == 27) ? a.out : nullptr, ga, scale, lane, wave, vb, vg, r0, T / 8);
        } else if (s == 4) {
            hgrn_a(Z, OA, (bf16*)(ws + WS_QD), UBv, (float*)(ws + WS_DV), a.lbl, l, lds, lane, wave, vb, vg, grp * 256, 256);
        } else if (s == 6) {
            hgrn_c((const bf16*)(ws + WS_SP), (const bf16*)(ws + WS_QD), OA, Z, MX, a.hgn + l * 64, lane, wave, vb, vg, grp * 256, 256);
        } else if (s == 5) {
            hgrn_b(UBv, (const float*)(ws + WS_DV), (bf16*)(ws + WS_SP), tid, vb, vg, grp * 4, 4);
            for (int u = vb; u < 64; u += vg) attn_unit(Z, MX, COS, SIN, a.sinks + l * 8, grp * 64 + u, lds, tid, lane, wave);
            for (int u = vb; u < 32; u += vg) sgu_unit(Z, MX, (const bf16*)(wl + OW_SW), a.sgln + l * 256, a.sgb + l * 512, grp * 32 + u, lds, tid, lane, wave);
        } else {
            { pg8::Gemm g{XN + ro * DM, (const bf16*)(wl + OW_G), T / 8, DM, DM}; pg8::StaticOrder S; S.init(T / 8, DM, vg, vb);
              pg8::EpiPlain E{SG + ro * DM, DM, RS + ro};
              pg8::gemm_phase<pg8::EpiPlain, pg8::StaticOrder, true, true>(glds, g, S, E, otid, wave0); }
            { pg8::Gemm g{(const bf16*)(ws + WS_PB) + ((size_t)l * T + ro) * PLE, (const bf16*)(wl + OW_P), T / 8, DM, PLE}; pg8::StaticOrder S; S.init(T / 8, DM, vg, vb);
              pg8::EpiPlain E{Dd + ro * DM, DM, nullptr};
              pg8::gemm_phase<pg8::EpiPlain, pg8::StaticOrder, true, true>(glds, g, S, E, otid, wave0); }
        }
        if (st != 27) { XcdBarrier bb; bb.ng = (unsigned)vg; bb.bar = (unsigned*)(ws + WS_CTL2) + 4096 * grp; bb.x = bx_; bb.st = bst + 2; xcd_barrier(bb); }
    }
}

extern "C" void kernel_launch(void* const* d_in, const int* in_sizes, int n_in, void* d_out, int out_size, void* d_ws, size_t ws_size, hipStream_t stream) {
    static int grid = 0;
    if (grid == 0) {
        if (n_in != 18 || ws_size < WS_END) { fprintf(stderr, "kernel_launch: unexpected n_in %d / ws_size %zu\n", n_in, ws_size); grid = -1; return; }
        int dev = 0, cus = 0, per_cu = 0;
        (void)hipGetDevice(&dev);
        (void)hipDeviceGetAttribute(&cus, hipDeviceAttributeMultiprocessorCount, dev);
        if (hipFuncSetAttribute((const void*)hybrid_fwd, hipFuncAttributeMaxDynamicSharedMemorySize, LDS_BYTES) != hipSuccess) { fprintf(stderr, "kernel_launch: hipFuncSetAttribute failed\n"); grid = -1; return; }
        if (hipOccupancyMaxActiveBlocksPerMultiprocessor(&per_cu, (const void*)hybrid_fwd, 512, LDS_BYTES) != hipSuccess || per_cu < 1) { fprintf(stderr, "kernel_launch: occupancy query gave %d\n", per_cu); per_cu = 1; }
        (void)hipGetLastError();
        grid = cus * per_cu;
        if (grid != 256) { fprintf(stderr, "kernel_launch: this kernel needs exactly 256 co-resident workgroups, got %d\n", grid); grid = -1; return; }
        fprintf(stderr, "kernel_launch: grid %d (cus %d x %d)\n", grid, cus, per_cu);
    }
    if (grid < 0) return;
    Args a{};
    a.x = (const float*)d_in[0]; a.p = (const float*)d_in[1]; a.pos = (const int*)d_in[2]; a.ng = (const float*)d_in[3]; a.w_in = (const float*)d_in[4]; a.w_out = (const float*)d_in[5];
    a.gu1 = (const float*)d_in[6]; a.d1 = (const float*)d_in[7]; a.gu2 = (const float*)d_in[8]; a.d2 = (const float*)d_in[9]; a.lbl = (const float*)d_in[10]; a.hgn = (const float*)d_in[11];
    a.sinks = (const float*)d_in[12]; a.sgln = (const float*)d_in[13]; a.sgw = (const float*)d_in[14]; a.sgb = (const float*)d_in[15]; a.plep = (const float*)d_in[16]; a.pleg = (const float*)d_in[17];
    a.out = (float*)d_out; a.ws = (unsigned char*)d_ws;
    if (hipMemsetAsync((char*)d_ws + WS_BAR, 0, 16384 + 9 * 16384 + 4096, stream) != hipSuccess) { fprintf(stderr, "kernel_launch: memset failed\n"); return; }
    void* args[] = {&a};
    hipError_t e = hipLaunchCooperativeKernel((const void*)hybrid_fwd, dim3(grid), dim3(512), args, LDS_BYTES, stream);
    if (e != hipSuccess) fprintf(stderr, "kernel_launch: cooperative launch failed: %s (grid %d)\n", hipGetErrorString(e), grid);
}
```

```cpp
#include <hip/hip_runtime.h>
#include <hip/hip_cooperative_groups.h>
#include <cstdio>
#include <cstdint>
namespace cg = cooperative_groups;
namespace pg8 {
#define PG8_LAS __attribute__((address_space(3)))
typedef unsigned short bf16_t;
typedef short bf16x8 __attribute__((ext_vector_type(8)));
typedef float f32x4 __attribute__((ext_vector_type(4)));
typedef unsigned u32x4 __attribute__((ext_vector_type(4)));
constexpr int BM = 256, BK = 64, HALF = 128, HTB = HALF * BK * 2  , STAGE_BYTES = 8 * HTB, NXCD = 8, WGM = 16;

__host__ __device__ __forceinline__ int lds_byte(int r, int c) { const int st = (r >> 4) * 2 + (c >> 5), rr = r & 15, cc = c & 31, ob = rr * 64 + cc * 2; return st * 1024 + (ob ^ (((ob >> 9) & 1) << 5)); }
__host__ __device__ __forceinline__ void stage_rc(int b, int& R, int& C) { const int st = b / 1024, sb = b % 1024, swz = sb ^ (((sb >> 9) & 1) << 5); R = (st >> 1) * 16 + swz / 64; C = (st & 1) * 32 + (swz % 64) / 2; }
__host__ __device__ __forceinline__ int perm32(int rho) { const int n = rho >> 4, i = rho & 15; return 8 * (i >> 2) + 4 * n + (i & 3); }

struct Unit { int pm, pn; };
struct Gemm { const bf16_t* A; const bf16_t* Bt; int M, N, K; };

struct StaticOrder {
    int nM, nN, nwg, G, c;
    __host__ __device__ void init(int M, int N, int G_, int c_) { nM = M / BM; nN = N / BM; nwg = nM * nN; G = G_; c = c_; }
    __host__ __device__ bool next(int i, Unit& u) const {
        const long L = (long)i * G + c; if (L >= nwg) return false;
        int wgid = (int)L; { const int q = nwg / NXCD, r = nwg % NXCD, xcd = wgid % NXCD, off = wgid / NXCD; wgid = (xcd < r ? xcd * (q + 1) : r * (q + 1) + (xcd - r) * q) + off; }
        const int nig = WGM * nN, gid = wgid / nig, fm = gid * WGM, gsz = (nM - fm) < WGM ? (nM - fm) : WGM;
        u.pm = fm + ((wgid % nig) % gsz); u.pn = (wgid % nig) / gsz; return true;
    }
    __device__ __forceinline__ void a_ready(const Unit&) const {}
    __device__ __forceinline__ void done(const Unit&) const {}
};
__device__ __forceinline__ unsigned cvt_pk_bf16(float lo, float hi) { unsigned r; asm volatile("v_cvt_pk_bf16_f32 %0, %1, %2" : "=v"(r) : "v"(lo), "v"(hi)); return r; }
typedef float f32x2 __attribute__((ext_vector_type(2)));
__device__ __forceinline__ float sigm(float x) { return __builtin_amdgcn_rcpf(1.0f + __expf(-x)); }
struct EpiPlain {
    static constexpr bool PERM = true, AFTER_DRAIN = false;
    bf16_t* O; int ldc; const float* rs;
    __device__ __forceinline__ void operator()(const f32x4 (&acc)[2][2][4][2], const Unit& u, int wr, int wc, int fr, int fq) const {
        const int row0 = u.pm * BM + wr * 64 + fr, col0 = u.pn * BM + wc * 32 + 8 * fq;
#pragma unroll
        for (int ai = 0; ai < 2; ++ai)
#pragma unroll
            for (int m = 0; m < 4; ++m) { bf16_t* rowp = O + (size_t)(row0 + ai * HALF + m * 16) * ldc + col0; const float r = rs ? rs[row0 + ai * HALF + m * 16] : 1.0f;
#pragma unroll
                for (int bj = 0; bj < 2; ++bj) { const f32x4 v0 = acc[ai][bj][m][0] * r, v1 = acc[ai][bj][m][1] * r;
                    u32x4 w; w.x = cvt_pk_bf16(v0[0], v0[1]); w.y = cvt_pk_bf16(v0[2], v0[3]); w.z = cvt_pk_bf16(v1[0], v1[1]); w.w = cvt_pk_bf16(v1[2], v1[3]);
                    *(u32x4*)(rowp + bj * HALF) = w; } }
    }
};
struct EpiSigmoid {
    static constexpr bool PERM = true, AFTER_DRAIN = false;
    bf16_t* O; int ldc;
    __device__ __forceinline__ void operator()(const f32x4 (&acc)[2][2][4][2], const Unit& u, int wr, int wc, int fr, int fq) const {
        const int row0 = u.pm * BM + wr * 64 + fr, col0 = u.pn * BM + wc * 32 + 8 * fq;
#pragma unroll
        for (int ai = 0; ai < 2; ++ai)
#pragma unroll
            for (int m = 0; m < 4; ++m) { bf16_t* rowp = O + (size_t)(row0 + ai * HALF + m * 16) * ldc + col0;
#pragma unroll
                for (int bj = 0; bj < 2; ++bj) { const f32x4 v0 = acc[ai][bj][m][0], v1 = acc[ai][bj][m][1];
                    u32x4 w; w.x = cvt_pk_bf16(sigm(v0[0]), sigm(v0[1])); w.y = cvt_pk_bf16(sigm(v0[2]), sigm(v0[3])); w.z = cvt_pk_bf16(sigm(v1[0]), sigm(v1[1])); w.w = cvt_pk_bf16(sigm(v1[2]), sigm(v1[3]));
                    *(u32x4*)(rowp + bj * HALF) = w; } }
    }
};
__device__ __forceinline__ float bflo(unsigned w) { return __uint_as_float(w << 16); }
__device__ __forceinline__ float bfhi(unsigned w) { return __uint_as_float(w & 0xffff0000u); }
struct EpiMulGate {
    static constexpr bool PERM = true, AFTER_DRAIN = false;
    bf16_t* O; const bf16_t* G; int ldc;
    __device__ __forceinline__ void operator()(const f32x4 (&acc)[2][2][4][2], const Unit& u, int wr, int wc, int fr, int fq) const {
        const int row0 = u.pm * BM + wr * 64 + fr, col0 = u.pn * BM + wc * 32 + 8 * fq;
#pragma unroll
        for (int ai = 0; ai < 2; ++ai)
#pragma unroll
            for (int m = 0; m < 4; ++m) { const size_t off = (size_t)(row0 + ai * HALF + m * 16) * ldc + col0;
#pragma unroll
                for (int bj = 0; bj < 2; ++bj) { const f32x4 v0 = acc[ai][bj][m][0], v1 = acc[ai][bj][m][1];
                    const u32x4 gv = *(const u32x4*)(G + off + bj * HALF);
                    u32x4 w; w.x = cvt_pk_bf16(v0[0] * bflo(gv.x), v0[1] * bfhi(gv.x)); w.y = cvt_pk_bf16(v0[2] * bflo(gv.y), v0[3] * bfhi(gv.y));
                    w.z = cvt_pk_bf16(v1[0] * bflo(gv.z), v1[1] * bfhi(gv.z)); w.w = cvt_pk_bf16(v1[2] * bflo(gv.w), v1[3] * bfhi(gv.w));
                    *(u32x4*)(O + off + bj * HALF) = w; }
                asm volatile("" ::: "memory"); }
    }
};
struct EpiSwiglu {
    static constexpr bool PERM = true, AFTER_DRAIN = false;
    bf16_t* O; int ldc; const float* rs;
    __device__ __forceinline__ void operator()(const f32x4 (&acc)[2][2][4][2], const Unit& u, int wr, int wc, int fr, int fq) const {
        const int row0 = u.pm * BM + wr * 64 + fr, col0 = u.pn * HALF + wc * 32 + 8 * fq;
#pragma unroll
        for (int ai = 0; ai < 2; ++ai)
#pragma unroll
            for (int m = 0; m < 4; ++m) { bf16_t* rowp = O + (size_t)(row0 + ai * HALF + m * 16) * ldc + col0; const float r = rs[row0 + ai * HALF + m * 16];
                const f32x4 g0 = acc[ai][0][m][0] * r, g1 = acc[ai][0][m][1] * r, u0 = acc[ai][1][m][0] * r, u1 = acc[ai][1][m][1] * r;
                u32x4 w; w.x = cvt_pk_bf16(g0[0] * sigm(g0[0]) * u0[0], g0[1] * sigm(g0[1]) * u0[1]); w.y = cvt_pk_bf16(g0[2] * sigm(g0[2]) * u0[2], g0[3] * sigm(g0[3]) * u0[3]);
                w.z = cvt_pk_bf16(g1[0] * sigm(g1[0]) * u1[0], g1[1] * sigm(g1[1]) * u1[1]); w.w = cvt_pk_bf16(g1[2] * sigm(g1[2]) * u1[2], g1[3] * sigm(g1[3]) * u1[3]);
                *(u32x4*)rowp = w; }
    }
};
template <class Epi, class Sched, bool ALIGN_EPI = false, bool SP2 = false>
__device__ __forceinline__ void gemm_phase(PG8_LAS unsigned char* lds, const Gemm g, const Sched& S, const Epi& E, const int tid, const int wid) {
    const int lane = tid & 63, wr = wid >> 2, wc = wid & 3, fr = lane & 15, fq = lane >> 4;
    const int K = g.K, nt = K / BK;
    unsigned voffA[2], voffB[2];
#pragma unroll
    for (int i = 0; i < 2; ++i) { int R, C; stage_rc(tid * 16 + i * 8192, R, C); const int Rb = Epi::PERM ? ((R & ~31) + perm32(R & 31)) : R;
        voffA[i] = (unsigned)(R * K + C) * 2u; voffB[i] = (unsigned)(Rb * K + C) * 2u; }
    const size_t kstep = (size_t)(BK * 2);
    const size_t hstep = (size_t)HALF * K * 2;
    const size_t tstep = 2 * hstep;
    const unsigned ldsw = (unsigned)wid * 1024u;
    const int aoff = lds_byte(wr * 64 + fr, fq * 8), boff = lds_byte(wc * 32 + fr, fq * 8);
#define PG8_SA(b, h) (((b) * 2 + (h)) * HTB)
#define PG8_SB(b, h) ((4 + (b) * 2 + (h)) * HTB)
#define PG8_STAGE(bufoff, gbase, voff) do { const unsigned long long _b = (unsigned long long)(gbase); \
        const char* _p = (const char*)(((unsigned long long)(unsigned)__builtin_amdgcn_readfirstlane((int)(unsigned)(_b >> 32)) << 32) | (unsigned)__builtin_amdgcn_readfirstlane((int)(unsigned)_b));   \
        _Pragma("unroll") for (int _i = 0; _i < 2; ++_i) \
        __builtin_amdgcn_global_load_lds((const unsigned*)(_p + (voff)[_i]), (PG8_LAS unsigned*)(lds + (bufoff) + ldsw + _i * 8192), 16, 0, 0); } while (0)
#define PG8_LDA(dst, b, h) do { _Pragma("unroll") for (int m = 0; m < 4; ++m) _Pragma("unroll") for (int k = 0; k < 2; ++k) dst[m][k] = *(const PG8_LAS bf16x8*)(lds + PG8_SA(b, h) + aoff + m * 2048 + k * 1024); } while (0)
#define PG8_LDB(dst, b, h) do { _Pragma("unroll") for (int n = 0; n < 2; ++n) _Pragma("unroll") for (int k = 0; k < 2; ++k) dst[n][k] = *(const PG8_LAS bf16x8*)(lds + PG8_SB(b, h) + boff + n * 2048 + k * 1024); } while (0)
#define PG8_MMA(ai, bj, At, Bt) do { __builtin_amdgcn_s_setprio(1); _Pragma("unroll") for (int m = 0; m < 4; ++m) _Pragma("unroll") for (int n = 0; n < 2; ++n) _Pragma("unroll") for (int k = 0; k < 2; ++k) \
        acc[ai][bj][m][n] = __builtin_amdgcn_mfma_f32_16x16x32_bf16(Bt[n][k], At[m][k], acc[ai][bj][m][n], 0, 0, 0); __builtin_amdgcn_s_setprio(0); } while (0)
#define PG8_WAIT_V(n) asm volatile("s_waitcnt vmcnt(" #n ")" ::: "memory")
#define PG8_WAIT_L(n) asm volatile("s_waitcnt lgkmcnt(" #n ")" ::: "memory")
#define PG8_BAR __builtin_amdgcn_s_barrier()
#define PG8_SCHED __builtin_amdgcn_sched_barrier(0)
    Unit cur, nxt; int ui = 0;
    if (!S.next(0, cur)) return;
    f32x4 acc[2][2][4][2];
#pragma unroll
    for (int a = 0; a < 2; ++a)
#pragma unroll
        for (int b = 0; b < 2; ++b)
#pragma unroll
            for (int m = 0; m < 4; ++m)
#pragma unroll
                for (int n = 0; n < 2; ++n) acc[a][b][m][n] = (f32x4){0.f, 0.f, 0.f, 0.f};
    bf16x8 At[4][2], B0[2][2], B1[2][2];
    const char* cA = (const char*)g.A + (size_t)cur.pm * tstep; const char* cB = (const char*)g.Bt + (size_t)cur.pn * tstep;
    S.a_ready(cur);
    if constexpr (SP2) {
        PG8_STAGE(PG8_SB(0, 0), cB, voffB); PG8_STAGE(PG8_SB(0, 1), cB + hstep, voffB); PG8_STAGE(PG8_SA(0, 0), cA, voffA); PG8_STAGE(PG8_SA(0, 1), cA + hstep, voffA);
        if (wr == 1) PG8_BAR;
        PG8_WAIT_V(2); PG8_BAR;
        PG8_STAGE(PG8_SB(1, 0), cB + kstep, voffB); PG8_STAGE(PG8_SA(1, 0), cA + kstep, voffA); PG8_STAGE(PG8_SB(1, 1), cB + hstep + kstep, voffB);
        PG8_WAIT_V(6); PG8_BAR;
    } else {
        PG8_STAGE(PG8_SB(0, 0), cB, voffB); PG8_STAGE(PG8_SA(0, 0), cA, voffA); PG8_STAGE(PG8_SB(0, 1), cB + hstep, voffB); PG8_STAGE(PG8_SA(0, 1), cA + hstep, voffA);
        if (wr == 1) PG8_BAR;
        PG8_WAIT_V(4); PG8_BAR;
        PG8_STAGE(PG8_SB(1, 0), cB + kstep, voffB); PG8_STAGE(PG8_SA(1, 0), cA + kstep, voffA); PG8_STAGE(PG8_SB(1, 1), cB + hstep + kstep, voffB);
        PG8_WAIT_V(6); PG8_BAR;
    }
    for (;;) {
        const bool has_next = S.next(ui + 1, nxt);
        const char* nA = has_next ? (const char*)g.A + (size_t)nxt.pm * tstep : cA; const char* nB = has_next ? (const char*)g.Bt + (size_t)nxt.pn * tstep : cB;
        for (int t = 0; t < nt; t += 2) {
            const bool last = (t == nt - 2);
            const char* a1 = cA + (size_t)(t + 1) * kstep;
            const char* a2 = last ? nA : cA + (size_t)(t + 2) * kstep; const char* b2 = last ? nB : cB + (size_t)(t + 2) * kstep;
            const char* a3 = a2 + kstep; const char* b3 = b2 + kstep;
            if (last && has_next) S.a_ready(nxt);
            if constexpr (SP2) {
            PG8_LDB(B0, 0, 0); PG8_LDB(B1, 0, 1); PG8_SCHED; PG8_LDA(At, 0, 0); PG8_STAGE(PG8_SA(1, 1), a1 + hstep, voffA);
            PG8_WAIT_V(8); PG8_WAIT_L(0); PG8_BAR; PG8_MMA(0, 0, At, B0); PG8_MMA(0, 1, At, B1); PG8_BAR; PG8_SCHED;
            PG8_LDA(At, 0, 1); PG8_STAGE(PG8_SB(0, 0), b2, voffB); PG8_STAGE(PG8_SB(0, 1), b2 + hstep, voffB); PG8_STAGE(PG8_SA(0, 0), a2, voffA);
            PG8_WAIT_V(8); PG8_WAIT_L(0); PG8_BAR; PG8_MMA(1, 0, At, B0); PG8_MMA(1, 1, At, B1); PG8_BAR; PG8_SCHED;
            PG8_LDB(B0, 1, 0); PG8_LDB(B1, 1, 1); PG8_SCHED; PG8_LDA(At, 1, 0); PG8_STAGE(PG8_SA(0, 1), a2 + hstep, voffA);
            PG8_WAIT_V(8); PG8_WAIT_L(0); PG8_BAR; PG8_MMA(0, 0, At, B0); PG8_MMA(0, 1, At, B1); PG8_BAR; PG8_SCHED;
            PG8_LDA(At, 1, 1); PG8_STAGE(PG8_SB(1, 0), b3, voffB); PG8_STAGE(PG8_SB(1, 1), b3 + hstep, voffB); PG8_STAGE(PG8_SA(1, 0), a3, voffA);
            PG8_WAIT_V(8); PG8_WAIT_L(0); PG8_BAR; PG8_MMA(1, 0, At, B0); PG8_MMA(1, 1, At, B1); PG8_BAR; PG8_SCHED;
            } else {
            PG8_LDB(B0, 0, 0); PG8_SCHED; PG8_LDA(At, 0, 0); PG8_STAGE(PG8_SA(1, 1), a1 + hstep, voffA);
            PG8_WAIT_L(8); PG8_BAR; PG8_WAIT_L(0); PG8_MMA(0, 0, At, B0); PG8_BAR; PG8_SCHED;
            PG8_LDB(B1, 0, 1); PG8_STAGE(PG8_SB(0, 0), b2, voffB);
            PG8_BAR; PG8_WAIT_L(0); PG8_MMA(0, 1, At, B1); PG8_BAR;
            PG8_LDA(At, 0, 1); PG8_STAGE(PG8_SA(0, 0), a2, voffA);
            PG8_BAR; PG8_WAIT_L(0); PG8_MMA(1, 0, At, B0); PG8_BAR; PG8_SCHED;
            PG8_STAGE(PG8_SB(0, 1), b2 + hstep, voffB);
            PG8_WAIT_V(6); PG8_BAR; PG8_MMA(1, 1, At, B1); PG8_BAR;
            PG8_LDB(B0, 1, 0); PG8_SCHED; PG8_LDA(At, 1, 0); PG8_STAGE(PG8_SA(0, 1), a2 + hstep, voffA);
            PG8_WAIT_L(8); PG8_BAR; PG8_WAIT_L(0); PG8_MMA(0, 0, At, B0); PG8_BAR; PG8_SCHED;
            PG8_LDB(B1, 1, 1); PG8_STAGE(PG8_SB(1, 0), b3, voffB);
            PG8_BAR; PG8_WAIT_L(0); PG8_MMA(0, 1, At, B1); PG8_BAR;
            PG8_LDA(At, 1, 1); PG8_STAGE(PG8_SA(1, 0), a3, voffA);
            PG8_BAR; PG8_WAIT_L(0); PG8_MMA(1, 0, At, B0); PG8_BAR; PG8_SCHED;
            PG8_STAGE(PG8_SB(1, 1), b3 + hstep, voffB);
            PG8_WAIT_V(6); PG8_BAR; PG8_MMA(1, 1, At, B1); PG8_BAR;
            }
        }
        if constexpr (ALIGN_EPI) { if (wr == 0) PG8_BAR; }
        if constexpr (!Epi::AFTER_DRAIN) { int l2 = __builtin_amdgcn_mbcnt_hi(~0u, __builtin_amdgcn_mbcnt_lo(~0u, 0u)); asm volatile("" : "+v"(l2)); E(acc, cur, wr, wc, l2 & 15, l2 >> 4); S.done(cur); }
        if (!has_next) break;
#pragma unroll
        for (int a = 0; a < 2; ++a)
#pragma unroll
            for (int b = 0; b < 2; ++b)
#pragma unroll
                for (int m = 0; m < 4; ++m)
#pragma unroll
                    for (int n = 0; n < 2; ++n) acc[a][b][m][n] = (f32x4){0.f, 0.f, 0.f, 0.f};
        cur = nxt; cA = nA; cB = nB; ++ui;
        if constexpr (ALIGN_EPI) { if (wr == 1) PG8_BAR; }
    }
    PG8_WAIT_V(0);
    if constexpr (!ALIGN_EPI) { if (wr == 0) PG8_BAR; }
    PG8_BAR;
    if constexpr (Epi::AFTER_DRAIN) { E.fused(acc, cur, wr, wc, fr, fq, lds, wid, lane); S.done(cur); }
#undef PG8_SA
#undef PG8_SB
#undef PG8_STAGE
#undef PG8_LDA
#undef PG8_LDB
#undef PG8_MMA
#undef PG8_WAIT_V
#undef PG8_WAIT_L
#undef PG8_BAR
#undef PG8_SCHED
}
}

constexpr int T = 32768, DM = 1024, SEQ = 4096, DFF = 2816, INW = 2304, PLE = 256;
constexpr size_t MiB = 1u << 20;
constexpr size_t WS_WL = 43 * MiB;
constexpr size_t OW_GU1 = 0, OW_D1 = 11 * MiB, OW_IN = 16 * MiB + MiB / 2, OW_OUT = 21 * MiB, OW_GU2 = 23 * MiB, OW_D2 = 34 * MiB, OW_G = 39 * MiB + MiB / 2, OW_P = 41 * MiB + MiB / 2, OW_SW = 42 * MiB;
constexpr size_t WS_COS = 86 * MiB, WS_SIN = 90 * MiB, WS_BAR = 94 * MiB, WS_RS = 94 * MiB + MiB / 4, WS_DV = 94 * MiB + MiB / 2, WS_QD = 432 * MiB, WS_SP = 448 * MiB, WS_PB = 95 * MiB, WS_XN = 128 * MiB, WS_D = 192 * MiB, WS_ACT = 256 * MiB, WS_CTL2 = WS_BAR + 16384, WS_END = 464 * MiB;
constexpr int LDS_BYTES = 147456;

typedef unsigned short bf16;
typedef short bf16x8 __attribute__((ext_vector_type(8)));
typedef float f32x4 __attribute__((ext_vector_type(4)));
typedef unsigned u32x4 __attribute__((ext_vector_type(4)));
typedef unsigned u32x2 __attribute__((ext_vector_type(2)));
#define LAS __attribute__((address_space(3)))
#define LDS_WAIT() asm volatile("s_waitcnt lgkmcnt(0)" ::: "memory")
__device__ __forceinline__ unsigned pk2(float lo, float hi) { unsigned r; asm("v_cvt_pk_bf16_f32 %0, %1, %2" : "=v"(r) : "v"(lo), "v"(hi)); return r; }
__device__ __forceinline__ unsigned f2bf(float f) { return pk2(f, 0.f) & 0xffffu; }
__device__ __forceinline__ float bf2f(unsigned short b) { return __uint_as_float(((unsigned)b) << 16); }
__device__ __forceinline__ float blo(unsigned w) { return __uint_as_float(w << 16); }
__device__ __forceinline__ float bhi(unsigned w) { return __uint_as_float(w & 0xffff0000u); }
__device__ __forceinline__ float shx(float v, int o, int lane) { return __int_as_float(__builtin_amdgcn_ds_bpermute((lane ^ o) << 2, __float_as_int(v))); }
__device__ __forceinline__ float wave_sum(float v, int lane) {
#pragma unroll
    for (int o = 1; o < 64; o <<= 1) v += shx(v, o, lane);
    return v;
}
__device__ __forceinline__ float gelu_tanh(float x) {
    const float y = 0.7978845608028654f * (x + 0.044715f * x * x * x);
    const float e = __expf(2.0f * y);
    const float th = 1.0f - 2.0f * __builtin_amdgcn_rcpf(e + 1.0f);
    return 0.5f * x * (1.0f + th);
}

struct Args { const float* x; const float* p; const int* pos; const float* ng; const float* w_in; const float* w_out; const float* gu1; const float* d1; const float* gu2; const float* d2;
              const float* lbl; const float* hgn; const float* sinks; const float* sgln; const float* sgw; const float* sgb; const float* plep; const float* pleg; float* out; unsigned char* ws; };

__device__ __forceinline__ void transpose_item(const float* W, int K, int N, bf16* WT, int k0, int n0, int drow0, float* scr, int lane, const float* gk) {
#pragma unroll
    for (int i = 0; i < 32; ++i) { const int kk = 2 * i + (lane >> 5); scr[kk * 33 + (lane & 31)] = W[(size_t)(k0 + kk) * N + n0 + (lane & 31)] * (gk ? gk[k0 + kk] : 1.0f); }
    LDS_WAIT(); asm volatile("" ::: "memory");
    const int c = lane & 7;
#pragma unroll
    for (int j = 0; j < 4; ++j) { const int n = (lane >> 3) + 8 * j; const float* s = scr + (8 * c) * 33 + n;
        u32x4 o; o.x = pk2(s[0 * 33], s[1 * 33]); o.y = pk2(s[2 * 33], s[3 * 33]); o.z = pk2(s[4 * 33], s[5 * 33]); o.w = pk2(s[6 * 33], s[7 * 33]);
        *(u32x4*)(WT + (size_t)(drow0 + n) * K + k0 + 8 * c) = o; }
    LDS_WAIT(); asm volatile("" ::: "memory");
}
__device__ __forceinline__ void transpose_plain(const float* W, int K, int N, bf16* WT, int item, float* scr, int lane, const float* gk) {
    const int nblk = N / 32, kb = item / nblk, nb = item % nblk;
    transpose_item(W, K, N, WT, 64 * kb, 32 * nb, 32 * nb, scr, lane, gk);
}
__device__ __forceinline__ void transpose_gu(const float* W, bf16* WT, int item, float* scr, int lane, const float* gk) {
    const int nblk = (2 * DFF) / 32, kb = item / nblk, nb = item % nblk, n0 = 32 * nb;
    int drow; if (n0 < DFF) { drow = 256 * (n0 / 128) + (n0 % 128); } else { const int c = n0 - DFF; drow = 256 * (c / 128) + 128 + (c % 128); }
    transpose_item(W, DM, 2 * DFF, WT, 64 * kb, n0, drow, scr, lane, gk);
}
__device__ __forceinline__ void x_row_to_bf16(const float* xrow, bf16* orow, float* rs, int lane) {
    const f32x4* xr = (const f32x4*)xrow + lane;
    float s = 0.f; u32x2* o8 = (u32x2*)orow + lane;
#pragma unroll
    for (int j = 0; j < 4; ++j) { const f32x4 v = xr[64 * j]; u32x2 w; w.x = pk2(v.x, v.y); w.y = pk2(v.z, v.w); o8[64 * j] = w;
        const float a0 = blo(w.x), a1 = bhi(w.x), a2 = blo(w.y), a3 = bhi(w.y); s += (a0 * a0 + a1 * a1) + (a2 * a2 + a3 * a3); }
    const float r = rsqrtf(wave_sum(s, lane) * (1.f / DM) + 1e-6f);
    if (lane == 0) *rs = r;
}
__device__ __forceinline__ void prologue(const Args& a, unsigned char* lds, int tid, int lane, int wave, int part, int vb, int vg, int it0, int it1) {
    unsigned char* ws = a.ws;
    float* scr = (float*)(lds + wave * 8448);
    const int gw = vb * 8 + wave, NGW = vg * 8;
    constexpr int I_GU = (DM / 64) * (2 * DFF / 32), I_D = (DFF / 64) * (DM / 32), I_IN = (DM / 64) * (INW / 32), I_SQ = (DM / 64) * (DM / 32), I_P = (PLE / 64) * (DM / 32);
    constexpr int I_LAYER = 2 * I_GU + 2 * I_D + I_IN + 2 * I_SQ + I_P;
    for (int it = it0 + gw; it < it1; it += NGW) {
        const int l = it / I_LAYER; int r = it % I_LAYER; unsigned char* wl = ws + (size_t)l * WS_WL; const float* ngl = a.ng + (size_t)l * 8 * DM;
        if (r < I_GU) { transpose_gu(a.gu1 + (size_t)l * DM * 2 * DFF, (bf16*)(wl + OW_GU1), r, scr, lane, ngl); continue; } r -= I_GU;
        if (r < I_GU) { transpose_gu(a.gu2 + (size_t)l * DM * 2 * DFF, (bf16*)(wl + OW_GU2), r, scr, lane, ngl + 4 * DM); continue; } r -= I_GU;
        if (r < I_D) { transpose_plain(a.d1 + (size_t)l * DFF * DM, DFF, DM, (bf16*)(wl + OW_D1), r, scr, lane, nullptr); continue; } r -= I_D;
        if (r < I_D) { transpose_plain(a.d2 + (size_t)l * DFF * DM, DFF, DM, (bf16*)(wl + OW_D2), r, scr, lane, nullptr); continue; } r -= I_D;
        if (r < I_IN) { transpose_plain(a.w_in + (size_t)l * DM * INW, DM, INW, (bf16*)(wl + OW_IN), r, scr, lane, ngl + 2 * DM); continue; } r -= I_IN;
        if (r < I_SQ) { transpose_plain(a.w_out + (size_t)l * DM * DM, DM, DM, (bf16*)(wl + OW_OUT), r, scr, lane, nullptr); continue; } r -= I_SQ;
        if (r < I_SQ) { transpose_plain(a.pleg + (size_t)l * DM * DM, DM, DM, (bf16*)(wl + OW_G), r, scr, lane, ngl + 6 * DM); continue; } r -= I_SQ;
        transpose_plain(a.plep + (size_t)l * PLE * DM, PLE, DM, (bf16*)(wl + OW_P), r, scr, lane, nullptr);
    }
    if (part != 0) return;
    const int gt = vb * 512 + tid, NGT = vg * 512;
    float* COS = (float*)(ws + WS_COS); float* SIN = (float*)(ws + WS_SIN);
    for (int e = gt; e < T * 32; e += NGT) {
        const int m = e >> 5, i = e & 31;
        const double inv = exp2(-(double)i * (13.287712379549449 / 32.0));
        const double ang = (double)a.pos[m] * inv;
        const double k = rint(ang * 0.15915494309189535);
        double r = fma(-k, 6.283185307179586, ang); r = fma(-k, 2.4492935982947064e-16, r);
        const float rf = (float)r;
        COS[e] = cosf(rf); SIN[e] = sinf(rf);
    }
    { const f32x4* src = (const f32x4*)a.p; u32x4* dst = (u32x4*)(ws + WS_PB);
      for (int e = gt; e < 2 * T * PLE / 8; e += NGT) { const f32x4 v0 = src[2 * e], v1 = src[2 * e + 1]; u32x4 w; w.x = pk2(v0.x, v0.y); w.y = pk2(v0.z, v0.w); w.z = pk2(v1.x, v1.y); w.w = pk2(v1.z, v1.w); dst[e] = w; } }
    for (int e = gt; e < 2 * 4 * 128 * 128; e += NGT) {
        const int l = e >> 16, r = e & 65535, t = (r >> 7) & 127, s = r & 127;
        ((bf16*)(ws + (size_t)l * WS_WL + OW_SW))[r] = (bf16)f2bf(s <= t ? a.sgw[e] : 0.f);
    }
    for (int m0 = gw; m0 < T; m0 += 4 * NGW) {
        f32x4 v[4][4]; float s[4];
#pragma unroll
        for (int r = 0; r < 4; ++r) { const f32x4* xr = (const f32x4*)(a.x + (size_t)(m0 + r * NGW) * DM) + lane;
#pragma unroll
            for (int j = 0; j < 4; ++j) v[r][j] = xr[64 * j]; }
#pragma unroll
        for (int r = 0; r < 4; ++r) { u32x2* o8 = (u32x2*)((bf16*)(ws + WS_XN) + (size_t)(m0 + r * NGW) * DM) + lane; float q = 0.f;
#pragma unroll
            for (int j = 0; j < 4; ++j) { u32x2 w; w.x = pk2(v[r][j].x, v[r][j].y); w.y = pk2(v[r][j].z, v[r][j].w); o8[64 * j] = w;
                const float a0 = blo(w.x), a1 = bhi(w.x), a2 = blo(w.y), a3 = bhi(w.y); q += (a0 * a0 + a1 * a1) + (a2 * a2 + a3 * a3); }
            s[r] = q; }
#pragma unroll
        for (int o = 1; o < 64; o <<= 1) {
#pragma unroll
            for (int r = 0; r < 4; ++r) s[r] += shx(s[r], o, lane); }
#pragma unroll
        for (int r = 0; r < 4; ++r) if (lane == 0) ((float*)(ws + WS_RS))[m0 + r * NGW] = rsqrtf(s[r] * (1.f / DM) + 1e-6f);
    }
}

__device__ __forceinline__ void unpack8(const u32x4 v, float* f) { f[0] = blo(v.x); f[1] = bhi(v.x); f[2] = blo(v.y); f[3] = bhi(v.y); f[4] = blo(v.z); f[5] = bhi(v.z); f[6] = blo(v.w); f[7] = bhi(v.w); }
__device__ __forceinline__ void norm_phase(const bf16* D, const bf16* Mul, const float* x32, bf16* HB, float* RS, float* out32, const float* ga, float scale, int lane, int wave, int vb, int vg, int r0, int nrows) {
    const int gw = vb * 8 + wave, NGW = vg * 8;
    constexpr int R = 4;
    const int RPW = nrows / NGW;
    for (int m0 = r0 + gw * RPW; m0 < r0 + (gw + 1) * RPW; m0 += R) {
        float h[R][16], d[R][16], s[R];
#pragma unroll
        for (int r = 0; r < R; ++r) { const int m = m0 + r;
            if (x32) {
#pragma unroll
                for (int j = 0; j < 2; ++j) { const f32x4* hp = (const f32x4*)(x32 + (size_t)m * DM + 512 * j + 8 * lane); const f32x4 a0 = hp[0], a1 = hp[1];
                    h[r][8 * j + 0] = a0.x; h[r][8 * j + 1] = a0.y; h[r][8 * j + 2] = a0.z; h[r][8 * j + 3] = a0.w; h[r][8 * j + 4] = a1.x; h[r][8 * j + 5] = a1.y; h[r][8 * j + 6] = a1.z; h[r][8 * j + 7] = a1.w; } }
            else {
#pragma unroll
                for (int j = 0; j < 2; ++j) unpack8(*(const u32x4*)(HB + (size_t)m * DM + 512 * j + 8 * lane), &h[r][8 * j]); }
#pragma unroll
            for (int j = 0; j < 2; ++j) unpack8(*(const u32x4*)(D + (size_t)m * DM + 512 * j + 8 * lane), &d[r][8 * j]);
            if (Mul) {
#pragma unroll
                for (int j = 0; j < 2; ++j) { float g[8]; unpack8(*(const u32x4*)(Mul + (size_t)m * DM + 512 * j + 8 * lane), g);
#pragma unroll
                    for (int i = 0; i < 8; ++i) d[r][8 * j + i] *= __builtin_amdgcn_rcpf(1.f + __expf(-g[i])); } }
        }
#pragma unroll
        for (int r = 0; r < R; ++r) { float q = 0.f;
#pragma unroll
            for (int i = 0; i < 16; ++i) q += d[r][i] * d[r][i];
            s[r] = q; }
#pragma unroll
        for (int o = 1; o < 64; o <<= 1) {
#pragma unroll
            for (int r = 0; r < R; ++r) s[r] += shx(s[r], o, lane); }
        float gg[16];
#pragma unroll
        for (int j = 0; j < 2; ++j) { const f32x4* gp = (const f32x4*)(ga + 512 * j + 8 * lane); const f32x4 a0 = gp[0], a1 = gp[1];
            gg[8 * j + 0] = a0.x; gg[8 * j + 1] = a0.y; gg[8 * j + 2] = a0.z; gg[8 * j + 3] = a0.w; gg[8 * j + 4] = a1.x; gg[8 * j + 5] = a1.y; gg[8 * j + 6] = a1.z; gg[8 * j + 7] = a1.w; }
        float s2[R];
#pragma unroll
        for (int r = 0; r < R; ++r) { const int m = m0 + r; const float rr = rsqrtf(s[r] * (1.f / DM) + 1e-6f) * scale; float q = 0.f;
#pragma unroll
            for (int i = 0; i < 16; ++i) h[r][i] += d[r][i] * rr * gg[i];
            if (out32) {
#pragma unroll
                for (int j = 0; j < 2; ++j) { f32x4* op = (f32x4*)(out32 + (size_t)m * DM + 512 * j + 8 * lane);
                    op[0] = (f32x4){h[r][8 * j + 0], h[r][8 * j + 1], h[r][8 * j + 2], h[r][8 * j + 3]}; op[1] = (f32x4){h[r][8 * j + 4], h[r][8 * j + 5], h[r][8 * j + 6], h[r][8 * j + 7]}; } }
            else {
#pragma unroll
                for (int j = 0; j < 2; ++j) { u32x4 w; w.x = pk2(h[r][8 * j + 0], h[r][8 * j + 1]); w.y = pk2(h[r][8 * j + 2], h[r][8 * j + 3]); w.z = pk2(h[r][8 * j + 4], h[r][8 * j + 5]); w.w = pk2(h[r][8 * j + 6], h[r][8 * j + 7]);
                    *(u32x4*)(HB + (size_t)m * DM + 512 * j + 8 * lane) = w; float f[8]; unpack8(w, f);
#pragma unroll
                    for (int i = 0; i < 8; ++i) q += f[i] * f[i]; } }
            s2[r] = q; }
        if (!out32) {
#pragma unroll
            for (int o = 1; o < 64; o <<= 1) {
#pragma unroll
                for (int r = 0; r < R; ++r) s2[r] += shx(s2[r], o, lane); }
#pragma unroll
            for (int r = 0; r < R; ++r) if (lane == 0) RS[m0 + r] = rsqrtf(s2[r] * (1.f / DM) + 1e-6f);
        }
    }
}

__device__ __forceinline__ void hgrn_phase(const bf16* Z, float* OA, const float* lbl, int layer, unsigned char* lds, int tid, int lane, int wave) {
    f32x4* FGQ = (f32x4*)lds;
    float* Vs = (float*)(lds + 65536);
    float* Pw = (float*)(lds + 65536 + 2048) + wave * (32 * 65);
    for (int unit = blockIdx.x; unit < 256; unit += gridDim.x) {
        const int b = unit >> 5, h = (unit >> 3) & 3, es = unit & 7, d = lane;
        float lb = 0.f; if (layer == 1) { const float l0 = lbl[h * 64 + d], l1 = lbl[256 + h * 64 + d]; lb = __builtin_amdgcn_rcpf(1.f + __expf(l0 - l1)); }
        const float oml = 1.f - lb;
        const bf16* zq = Z + (size_t)(b * SEQ) * INW + h * 64 + d;
        const bf16* zv = Z + (size_t)(b * SEQ) * INW + 512 + h * 64 + es * 8 + (tid & 7);
        unsigned short rq[4], rf[4], rv = 0;
#pragma unroll
        for (int k = 0; k < 4; ++k) { const size_t ro = (size_t)(wave + 8 * k) * INW; rq[k] = zq[ro]; rf[k] = zq[ro + 256]; }
        if (tid < 256) rv = zv[(size_t)(tid >> 3) * INW];
        float S = 0.f;
        for (int c = 0; c < 128; ++c) {
            const int buf = c & 1;
#pragma unroll
            for (int k = 0; k < 4; ++k) { const int t = wave + 8 * k; float x = bf2f(rf[k]); x = fminf(fmaxf(x, -30.f), 30.f);
                const float e = __expf(-x), rr = __builtin_amdgcn_rcpf(1.f + e); const float f = lb + oml * rr, g = oml * (e * rr);
                FGQ[(buf * 32 + t) * 64 + d] = (f32x4){f, g, bf2f(rq[k]), 0.f}; }
            if (tid < 256) Vs[buf * 256 + tid] = bf2f(rv);
            __syncthreads();
            if (c + 1 < 128) {
#pragma unroll
                for (int k = 0; k < 4; ++k) { const size_t ro = (size_t)((c + 1) * 32 + wave + 8 * k) * INW; rq[k] = zq[ro]; rf[k] = zq[ro + 256]; }
                if (tid < 256) rv = zv[(size_t)((c + 1) * 32 + (tid >> 3)) * INW];
            }
#pragma unroll
            for (int t = 0; t < 32; ++t) { const f32x4 x = FGQ[(buf * 32 + t) * 64 + lane]; const float v = Vs[buf * 256 + t * 8 + wave];
                S = fmaf(x.x, S, x.y * v); Pw[t * 65 + lane] = x.z * S; }
            const int tt = lane & 31, hf = lane >> 5; float s = 0.f;
#pragma unroll
            for (int j = 0; j < 32; ++j) s += Pw[tt * 65 + hf * 32 + j];
            s += shx(s, 32, lane);
            if (lane < 32) OA[(size_t)(b * SEQ + c * 32 + tt) * 256 + h * 64 + es * 8 + wave] = s;
        }
        __syncthreads();
    }
}

#define MFMA16(a, b, c) __builtin_amdgcn_mfma_f32_16x16x32_bf16((a), (b), (c), 0, 0, 0)
__device__ __forceinline__ bf16x8 mk8(u32x2 lo, u32x2 hi) { u32x4 w; w.x = lo.x; w.y = lo.y; w.z = hi.x; w.w = hi.y; return __builtin_bit_cast(bf16x8, w); }

__device__ __forceinline__ float bfx(const u32x4& v, int i) { const unsigned w = (i < 2) ? v.x : (i < 4) ? v.y : (i < 6) ? v.z : v.w; return (i & 1) ? bhi(w) : blo(w); }
__device__ __forceinline__ void hgrn_a(const bf16* Z, float* OA, bf16* QD, float* UB, float* DV, const float* lbl, int layer, unsigned char* lds, int lane, int wave, int vb, int vg, int c0, int nch) {
    bf16* Qs = (bf16*)lds; bf16* Kn = (bf16*)(lds + 9216); bf16* KlT = (bf16*)(lds + 18432); bf16* Vt = (bf16*)(lds + 27648);
    const int fr = lane & 15, fq = lane >> 4, t = lane;
    u32x4 nq = {0u, 0u, 0u, 0u}, nx = nq, nv = nq;
    if (c0 + vb < c0 + nch) { const int c = c0 + vb, bh = c >> 6, b = bh >> 2, h = bh & 3, n = c & 63; const bf16* zr = Z + (size_t)(b * SEQ + n * 64 + t) * INW + h * 64 + 8 * wave;
        nq = *(const u32x4*)zr; nx = *(const u32x4*)(zr + 256); nv = *(const u32x4*)(zr + 512); }
    for (int c = c0 + vb; c < c0 + nch; c += vg) {
        const int bh = c >> 6, b = bh >> 2, h = bh & 3, n = c & 63, row0 = b * SEQ + n * 64;
        const u32x4 qv = nq, xv = nx, vv = nv;
        float lf[8], kk[8];
#pragma unroll
        for (int dd = 0; dd < 8; ++dd) { float lb = 0.f; if (layer == 1) { const float l0 = lbl[h * 64 + 8 * wave + dd], l1 = lbl[256 + h * 64 + 8 * wave + dd]; lb = __builtin_amdgcn_rcpf(1.f + __expf(l0 - l1)); }
            const float oml = 1.f - lb; float x = bfx(xv, dd); x = fminf(fmaxf(x, -30.f), 30.f);
            const float e = __expf(-x), rr = __builtin_amdgcn_rcpf(1.f + e); const float f = lb + oml * rr; kk[dd] = oml * (e * rr); lf[dd] = __logf(f); }
#pragma unroll
        for (int o = 1; o < 64; o <<= 1) {
#pragma unroll
            for (int dd = 0; dd < 8; ++dd) { const float y = __int_as_float(__builtin_amdgcn_ds_bpermute(((lane - o) & 63) << 2, __float_as_int(lf[dd]))); lf[dd] += (lane >= o) ? y : 0.f; } }
        unsigned qd[8], kn[8];
#pragma unroll
        for (int dd = 0; dd < 8; ++dd) { const float bl = __int_as_float(__builtin_amdgcn_readlane(__float_as_int(lf[dd]), 63)); const float bb = lf[dd];
            qd[dd] = f2bf(bfx(qv, dd) * __expf(bb)); kn[dd] = f2bf(kk[dd] * __expf(fminf(-bb, 80.f)));
            KlT[(8 * wave + dd) * 72 + t] = (bf16)f2bf(kk[dd] * __expf(bl - bb));
            Vt[(8 * wave + dd) * 72 + t] = (bf16)((dd & 1) ? ((dd < 2 ? vv.x : dd < 4 ? vv.y : dd < 6 ? vv.z : vv.w) >> 16) : ((dd < 2 ? vv.x : dd < 4 ? vv.y : dd < 6 ? vv.z : vv.w) & 0xffffu));
            if (lane == 63) DV[c * 64 + 8 * wave + dd] = __expf(bb); }
        { u32x4 w; w.x = qd[0] | (qd[1] << 16); w.y = qd[2] | (qd[3] << 16); w.z = qd[4] | (qd[5] << 16); w.w = qd[6] | (qd[7] << 16);
          *(u32x4*)(Qs + t * 72 + 8 * wave) = w; *(u32x4*)(QD + (size_t)(row0 + t) * 256 + h * 64 + 8 * wave) = w;
          u32x4 k2; k2.x = kn[0] | (kn[1] << 16); k2.y = kn[2] | (kn[3] << 16); k2.z = kn[4] | (kn[5] << 16); k2.w = kn[6] | (kn[7] << 16);
          *(u32x4*)(Kn + t * 72 + 8 * wave) = k2; }
        __syncthreads();
        if (c + vg < c0 + nch) { const int c2 = c + vg, bh2 = c2 >> 6, b2 = bh2 >> 2, h2 = bh2 & 3, n2 = c2 & 63; const bf16* zr = Z + (size_t)(b2 * SEQ + n2 * 64 + t) * INW + h2 * 64 + 8 * wave;
            nq = *(const u32x4*)zr; nx = *(const u32x4*)(zr + 256); nv = *(const u32x4*)(zr + 512); }
        const int it = wave & 3, eh = wave >> 2;
        bf16x8 qf[2];
#pragma unroll
        for (int ks = 0; ks < 2; ++ks) qf[ks] = *(const bf16x8*)(Qs + (16 * it + fr) * 72 + 32 * ks + 8 * fq);
        f32x4 aa[4];
#pragma unroll
        for (int jt = 0; jt < 4; ++jt) { f32x4 acc = {0.f, 0.f, 0.f, 0.f};
            if (jt <= it) {
#pragma unroll
                for (int ks = 0; ks < 2; ++ks) { const bf16x8 kf = *(const bf16x8*)(Kn + (16 * jt + fr) * 72 + 32 * ks + 8 * fq); acc = MFMA16(kf, qf[ks], acc); }
#pragma unroll
                for (int r = 0; r < 4; ++r) acc[r] = (16 * jt + 4 * fq + r <= 16 * it + fr) ? acc[r] : 0.f; }
            aa[jt] = acc; }
#pragma unroll
        for (int ee = 0; ee < 2; ++ee) { const int et = 2 * eh + ee; f32x4 o = {0.f, 0.f, 0.f, 0.f};
#pragma unroll
            for (int k2 = 0; k2 < 2; ++k2) { u32x4 pw; pw.x = pk2(aa[2 * k2][0], aa[2 * k2][1]); pw.y = pk2(aa[2 * k2][2], aa[2 * k2][3]); pw.z = pk2(aa[2 * k2 + 1][0], aa[2 * k2 + 1][1]); pw.w = pk2(aa[2 * k2 + 1][2], aa[2 * k2 + 1][3]);
                const bf16* vrow = Vt + (16 * et + fr) * 72; const u32x2 lo = *(const u32x2*)(vrow + 32 * k2 + 4 * fq), hi = *(const u32x2*)(vrow + 32 * k2 + 16 + 4 * fq);
                o = MFMA16(mk8(lo, hi), __builtin_bit_cast(bf16x8, pw), o); }
            *(f32x4*)(OA + (size_t)(row0 + 16 * it + fr) * 256 + h * 64 + 16 * et + 4 * fq) = o; }
#pragma unroll
        for (int ee = 0; ee < 2; ++ee) { const int et = 2 * eh + ee, dt = it; f32x4 u = {0.f, 0.f, 0.f, 0.f};
#pragma unroll
            for (int ks = 0; ks < 2; ++ks) { const bf16x8 xf = *(const bf16x8*)(KlT + (16 * dt + fr) * 72 + 32 * ks + 8 * fq); const bf16x8 yf = *(const bf16x8*)(Vt + (16 * et + fr) * 72 + 32 * ks + 8 * fq); u = MFMA16(xf, yf, u); }
            *(f32x4*)(UB + (size_t)c * 4096 + (16 * et + fr) * 64 + 16 * dt + 4 * fq) = u; }
        __syncthreads();
    }
}
__device__ __forceinline__ void hgrn_b(const float* __restrict__ UB, const float* __restrict__ DV, bf16* __restrict__ SP, int tid, int vb, int vg, int bh0, int nbh) {
    for (int gid = vb * 512 + tid; gid < nbh * 4096; gid += vg * 512) {
        const int bh = bh0 + (gid >> 12), ed = gid & 4095, d = ed & 63; float S = 0.f;
#pragma unroll 8
        for (int n = 0; n < 64; ++n) { const int c = bh * 64 + n; SP[(size_t)c * 4096 + ed] = (bf16)f2bf(S); S = DV[c * 64 + d] * S + UB[(size_t)c * 4096 + ed]; }
    }
}
__device__ __forceinline__ void hgrn_c(const bf16* SP, const bf16* QD, const float* OA, const bf16* Z, bf16* MX, const float* hgn, int lane, int wave, int vb, int vg, int c0, int nch) {
    const int gw = vb * 8 + wave, NGW = vg * 8, fr = lane & 15, fq = lane >> 4;
    for (int wt = gw; wt < 4 * nch; wt += NGW) {
        const int c = c0 + (wt >> 2), it = wt & 3, bh = c >> 6, b = bh >> 2, h = bh & 3, n = c & 63, row = b * SEQ + n * 64 + 16 * it + fr;
        f32x4 o[4];
#pragma unroll
        for (int et = 0; et < 4; ++et) o[et] = *(const f32x4*)(OA + (size_t)row * 256 + h * 64 + 16 * et + 4 * fq);
#pragma unroll
        for (int ks = 0; ks < 2; ++ks) { const bf16x8 qf = *(const bf16x8*)(QD + (size_t)row * 256 + h * 64 + 32 * ks + 8 * fq);
#pragma unroll
            for (int et = 0; et < 4; ++et) { const bf16x8 sf = *(const bf16x8*)(SP + (size_t)c * 4096 + (16 * et + fr) * 64 + 32 * ks + 8 * fq); o[et] = MFMA16(sf, qf, o[et]); } }
        float ss = 0.f;
#pragma unroll
        for (int et = 0; et < 4; ++et) ss += (o[et][0] * o[et][0] + o[et][1] * o[et][1]) + (o[et][2] * o[et][2] + o[et][3] * o[et][3]);
        ss += shx(ss, 16, lane); ss += shx(ss, 32, lane);
        const float r = rsqrtf(ss * (1.f / 64.f) + 1e-6f);
#pragma unroll
        for (int et = 0; et < 4; ++et) { const int e0 = 16 * et + 4 * fq; const f32x4 gain = *(const f32x4*)(hgn + e0);
            const u32x2 gv = *(const u32x2*)(Z + (size_t)row * INW + 768 + h * 64 + e0);
            const float g0 = __builtin_amdgcn_rcpf(1.f + __expf(-blo(gv.x))), g1 = __builtin_amdgcn_rcpf(1.f + __expf(-bhi(gv.x))), g2 = __builtin_amdgcn_rcpf(1.f + __expf(-blo(gv.y))), g3 = __builtin_amdgcn_rcpf(1.f + __expf(-bhi(gv.y)));
            u32x2 w; w.x = pk2(o[et][0] * r * gain.x * g0, o[et][1] * r * gain.y * g1); w.y = pk2(o[et][2] * r * gain.z * g2, o[et][3] * r * gain.w * g3);
            *(u32x2*)(MX + (size_t)row * DM + h * 64 + e0) = w; }
    }
}
__device__ __forceinline__ void attn_unit(const bf16* Z, bf16* MX, const float* COS, const float* SIN, const float* sinks, int unit, unsigned char* lds, int tid, int lane, int wave) {
    bf16* Ks = (bf16*)lds;
    bf16* Vt = (bf16*)(lds + 36864);
    bf16* Qs4 = (bf16*)(lds + 36864 + 33792);
    asm volatile("" : "+v"(tid)); lane = tid & 63;
    const int b = unit >> 6, n = (unit >> 1) & 31, kv = unit & 1, fr = lane & 15, fq = lane >> 4;
    const int tok0 = b * SEQ + n * 128 - 128;
#pragma unroll
    for (int k = 0; k < 2; ++k) { const int idx = tid + 512 * k, sj = idx >> 2, g = idx & 3, row = tok0 + sj;
        u32x4 o1 = {0u, 0u, 0u, 0u}, o2 = {0u, 0u, 0u, 0u};
        if (n > 0 || sj >= 128) { const bf16* zr = Z + (size_t)row * INW + 1536 + kv * 64 + 8 * g; const u32x4 xa = *(const u32x4*)zr, xb = *(const u32x4*)(zr + 32);
            const f32x4* cp = (const f32x4*)(COS + row * 32 + 8 * g); const f32x4* sp = (const f32x4*)(SIN + row * 32 + 8 * g); const f32x4 c0 = cp[0], c1 = cp[1], s0 = sp[0], s1 = sp[1];
            float x1[8], x2[8]; unpack8(xa, x1); unpack8(xb, x2);
            const float cc[8] = {c0.x, c0.y, c0.z, c0.w, c1.x, c1.y, c1.z, c1.w}, ss[8] = {s0.x, s0.y, s0.z, s0.w, s1.x, s1.y, s1.z, s1.w};
            float r1[8], r2[8];
#pragma unroll
            for (int i = 0; i < 8; ++i) { r1[i] = x1[i] * cc[i] - x2[i] * ss[i]; r2[i] = x2[i] * cc[i] + x1[i] * ss[i]; }
            o1.x = pk2(r1[0], r1[1]); o1.y = pk2(r1[2], r1[3]); o1.z = pk2(r1[4], r1[5]); o1.w = pk2(r1[6], r1[7]);
            o2.x = pk2(r2[0], r2[1]); o2.y = pk2(r2[2], r2[3]); o2.z = pk2(r2[4], r2[5]); o2.w = pk2(r2[6], r2[7]); }
        *(u32x4*)(Ks + sj * 72 + 8 * g) = o1; *(u32x4*)(Ks + sj * 72 + 32 + 8 * g) = o2; }
#pragma unroll
    for (int k = 0; k < 4; ++k) { const int idx = tid + 512 * k, sj = idx & 255, g8 = idx >> 8, row = tok0 + sj;
        u32x4 v = {0u, 0u, 0u, 0u};
        if (n > 0 || sj >= 128) v = *(const u32x4*)(Z + (size_t)row * INW + 1664 + kv * 64 + 8 * g8);
        bf16* vp = Vt + (8 * g8) * 264 + sj;
        vp[0 * 264] = (bf16)(v.x & 0xffffu); vp[1 * 264] = (bf16)(v.x >> 16); vp[2 * 264] = (bf16)(v.y & 0xffffu); vp[3 * 264] = (bf16)(v.y >> 16);
        vp[4 * 264] = (bf16)(v.z & 0xffffu); vp[5 * 264] = (bf16)(v.z >> 16); vp[6 * 264] = (bf16)(v.w & 0xffffu); vp[7 * 264] = (bf16)(v.w >> 16); }
    { const int qi = tid >> 2, g = tid & 3, row = b * SEQ + n * 128 + qi;
      const f32x4* cp = (const f32x4*)(COS + row * 32 + 8 * g); const f32x4* sp = (const f32x4*)(SIN + row * 32 + 8 * g); const f32x4 c0 = cp[0], c1 = cp[1], s0 = sp[0], s1 = sp[1];
      const float cc[8] = {c0.x, c0.y, c0.z, c0.w, c1.x, c1.y, c1.z, c1.w}, ss[8] = {s0.x, s0.y, s0.z, s0.w, s1.x, s1.y, s1.z, s1.w};
#pragma unroll
      for (int hh = 0; hh < 4; ++hh) { const bf16* zr = Z + (size_t)row * INW + 1024 + (kv * 4 + hh) * 64 + 8 * g; const u32x4 xa = *(const u32x4*)zr, xb = *(const u32x4*)(zr + 32);
          float x1[8], x2[8]; unpack8(xa, x1); unpack8(xb, x2); float r1[8], r2[8];
#pragma unroll
          for (int i = 0; i < 8; ++i) { r1[i] = (x1[i] * cc[i] - x2[i] * ss[i]) * 0.125f; r2[i] = (x2[i] * cc[i] + x1[i] * ss[i]) * 0.125f; }
          u32x4 o1, o2; o1.x = pk2(r1[0], r1[1]); o1.y = pk2(r1[2], r1[3]); o1.z = pk2(r1[4], r1[5]); o1.w = pk2(r1[6], r1[7]);
          o2.x = pk2(r2[0], r2[1]); o2.y = pk2(r2[2], r2[3]); o2.z = pk2(r2[4], r2[5]); o2.w = pk2(r2[6], r2[7]);
          *(u32x4*)(Qs4 + hh * 9216 + qi * 72 + 8 * g) = o1; *(u32x4*)(Qs4 + hh * 9216 + qi * 72 + 32 + 8 * g) = o2; } }
    __syncthreads();
    for (int g = 0; g < 4; ++g) {
        const int hq = kv * 4 + g; const bf16* Qs = Qs4 + g * 9216;
        bf16x8 qf[2];
#pragma unroll
        for (int ks = 0; ks < 2; ++ks) qf[ks] = *(const bf16x8*)(Qs + (16 * wave + fr) * 72 + 32 * ks + 8 * fq);
        f32x4 sacc[9];
#pragma unroll
        for (int j = 0; j < 9; ++j) { f32x4 acc = {0.f, 0.f, 0.f, 0.f};
#pragma unroll
            for (int ks = 0; ks < 2; ++ks) { const bf16x8 kf = *(const bf16x8*)(Ks + (16 * (wave + j) + fr) * 72 + 32 * ks + 8 * fq); acc = MFMA16(kf, qf[ks], acc); }
            sacc[j] = acc; }
        const int qi = 16 * wave + fr; const float sink = sinks[hq];
        float mx = -1e30f;
#pragma unroll
        for (int j = 0; j < 9; ++j) { const float penu = (n > 0 || wave + j >= 8) ? 0.f : -1e30f;
#pragma unroll
            for (int r = 0; r < 4; ++r) { float pen = penu; const int delta = 16 * j + 4 * fq + r - fr;
                if (j == 0) pen = (delta > 0) ? pen : -1e30f;
                if (j == 8) pen = (delta <= 128) ? pen : -1e30f;
                const float s = sacc[j][r] + pen; sacc[j][r] = s; mx = fmaxf(mx, s); } }
        mx = fmaxf(mx, shx(mx, 16, lane)); mx = fmaxf(mx, shx(mx, 32, lane)); mx = fmaxf(mx, sink);
        float sum = 0.f;
#pragma unroll
        for (int j = 0; j < 9; ++j)
#pragma unroll
            for (int r = 0; r < 4; ++r) { const float p = __expf(sacc[j][r] - mx); sacc[j][r] = p; sum += p; }
        sum += shx(sum, 16, lane); sum += shx(sum, 32, lane);
        const float inv = 1.f / (sum + __expf(sink - mx));
        f32x4 o[4];
#pragma unroll
        for (int dt = 0; dt < 4; ++dt) o[dt] = (f32x4){0.f, 0.f, 0.f, 0.f};
#pragma unroll
        for (int kk = 0; kk < 5; ++kk) { const int j0 = 2 * kk, j1 = 2 * kk + 1;
            u32x4 pw; pw.x = pk2(sacc[j0][0], sacc[j0][1]); pw.y = pk2(sacc[j0][2], sacc[j0][3]);
            if (j1 < 9) { pw.z = pk2(sacc[j1 < 9 ? j1 : 8][0], sacc[j1 < 9 ? j1 : 8][1]); pw.w = pk2(sacc[j1 < 9 ? j1 : 8][2], sacc[j1 < 9 ? j1 : 8][3]); } else { pw.z = 0u; pw.w = 0u; }
            const bf16x8 pf = __builtin_bit_cast(bf16x8, pw);
            const int key0 = 16 * (wave + j0) + 4 * fq, key1 = (j1 < 9) ? 16 * (wave + j1) + 4 * fq : key0;
#pragma unroll
            for (int dt = 0; dt < 4; ++dt) { const bf16* vrow = Vt + (16 * dt + fr) * 264; const u32x2 lo = *(const u32x2*)(vrow + key0), hi = *(const u32x2*)(vrow + key1);
                o[dt] = MFMA16(mk8(lo, hi), pf, o[dt]); } }
        bf16* orow = MX + (size_t)(b * SEQ + n * 128 + qi) * DM + 256 + hq * 64 + 4 * fq;
#pragma unroll
        for (int dt = 0; dt < 4; ++dt) { u32x2 w; w.x = pk2(o[dt][0] * inv, o[dt][1] * inv); w.y = pk2(o[dt][2] * inv, o[dt][3] * inv); *(u32x2*)(orow + 16 * dt) = w; }
    }
    __syncthreads();
}
__device__ __forceinline__ void sgu_unit(const bf16* Z, bf16* MX, const bf16* SW, const float* lng, const float* sgb, int unit, unsigned char* lds, int tid, int lane, int wave) {
    bf16* Vt = (bf16*)lds;
    const int b = unit >> 5, nc = unit & 31, row0 = b * SEQ + nc * 128, fr = lane & 15, fq = lane >> 4;
#pragma unroll 4
    for (int k = 0; k < 16; ++k) { const int t = wave + 8 * k; const bf16* zr = Z + (size_t)(row0 + t) * INW + 2048;
        float x[4]; float s = 0.f;
#pragma unroll
        for (int i = 0; i < 4; ++i) { x[i] = gelu_tanh(bf2f(zr[lane + 64 * i])); s += x[i]; }
        const float mu = wave_sum(s, lane) * (1.f / 256.f); float q = 0.f;
#pragma unroll
        for (int i = 0; i < 4; ++i) { x[i] -= mu; q += x[i] * x[i]; }
        const float rstd = rsqrtf(wave_sum(q, lane) * (1.f / 256.f) + 1e-6f);
#pragma unroll
        for (int i = 0; i < 4; ++i) { const int c = lane + 64 * i; Vt[c * 132 + t] = (bf16)f2bf(x[i] * rstd * lng[c]); } }
    __syncthreads();
    const int nks = (wave >> 1) + 1, t = 16 * wave + fr;
    for (int g = 0; g < 4; ++g) {
        f32x4 acc[4];
#pragma unroll
        for (int dt = 0; dt < 4; ++dt) acc[dt] = (f32x4){0.f, 0.f, 0.f, 0.f};
        bf16x8 wfr[4];
#pragma unroll
        for (int ks = 0; ks < 4; ++ks) { const int kc = (ks < nks) ? ks : 0; wfr[ks] = *(const bf16x8*)(SW + (size_t)(g * 128 + t) * 128 + 32 * kc + 8 * fq); }
#pragma unroll
        for (int ks = 0; ks < 4; ++ks) if (ks < nks) {
#pragma unroll
            for (int dt = 0; dt < 4; ++dt) { const bf16* vrow = Vt + (g * 64 + 16 * dt + fr) * 132 + 32 * ks + 8 * fq; const u32x2 lo = *(const u32x2*)vrow, hi = *(const u32x2*)(vrow + 4);
                acc[dt] = MFMA16(mk8(lo, hi), wfr[ks], acc[dt]); } }
        const float bias = sgb[g * 128 + t];
        const bf16* urow = Z + (size_t)(row0 + t) * INW + 1792 + g * 64 + 4 * fq; bf16* orow = MX + (size_t)(row0 + t) * DM + 768 + g * 64 + 4 * fq;
#pragma unroll
        for (int dt = 0; dt < 4; ++dt) { const u32x2 uv = *(const u32x2*)(urow + 16 * dt);
            u32x2 w; w.x = pk2(gelu_tanh(blo(uv.x)) * (acc[dt][0] + bias), gelu_tanh(bhi(uv.x)) * (acc[dt][1] + bias)); w.y = pk2(gelu_tanh(blo(uv.y)) * (acc[dt][2] + bias), gelu_tanh(bhi(uv.y)) * (acc[dt][3] + bias));
            *(u32x2*)(orow + 16 * dt) = w; }
    }
    __syncthreads();
}
__device__ __forceinline__ void hgrn_epilogue(const float* OA, const bf16* Z, bf16* MX, const float* hgn, int lane, int wave) {
    const int gw = blockIdx.x * 8 + wave, NGW = gridDim.x * 8;
    const f32x4 gain = ((const f32x4*)hgn)[lane & 15];
    for (int m = gw; m < T; m += NGW) {
        const f32x4 o = ((const f32x4*)(OA + (size_t)m * 256))[lane];
        float ss = (o.x * o.x + o.y * o.y) + (o.z * o.z + o.w * o.w);
        ss += shx(ss, 1, lane); ss += shx(ss, 2, lane); ss += shx(ss, 4, lane); ss += shx(ss, 8, lane);
        const float r = rsqrtf(ss * (1.f / 64.f) + 1e-6f);
        const u32x2 gv = *(const u32x2*)(Z + (size_t)m * INW + 768 + 4 * lane);
        const float g0 = __builtin_amdgcn_rcpf(1.f + __expf(-blo(gv.x))), g1 = __builtin_amdgcn_rcpf(1.f + __expf(-bhi(gv.x))), g2 = __builtin_amdgcn_rcpf(1.f + __expf(-blo(gv.y))), g3 = __builtin_amdgcn_rcpf(1.f + __expf(-bhi(gv.y)));
        u32x2 w; w.x = pk2(o.x * r * gain.x * g0, o.y * r * gain.y * g1); w.y = pk2(o.z * r * gain.z * g2, o.w * r * gain.w * g3);
        *(u32x2*)(MX + (size_t)m * DM + 4 * lane) = w;
    }
}

#define RLX_AGENT __ATOMIC_RELAXED, __HIP_MEMORY_SCOPE_AGENT
#define XB_TMO      128
#define XB_XCNT(j)  (256  + 64 * (j))
#define XB_XSUB(j)  (1280 + 64 * (j))
#define XB_XGEN(j)  (2304 + 64 * (j))
#define XB_TOP      3328
#define XB_TOPGEN   3392
#define XCD_BAR_WORDS 3456
#define XB_SPIN_CAP (1u << 18)

__device__ __forceinline__ unsigned xb_ld(unsigned* p)              { return __hip_atomic_load(p, __ATOMIC_RELAXED, __HIP_MEMORY_SCOPE_AGENT); }
__device__ __forceinline__ unsigned xb_add(unsigned* p, unsigned v) { return __hip_atomic_fetch_add(p, v, __ATOMIC_RELAXED, __HIP_MEMORY_SCOPE_AGENT); }
__device__ __forceinline__ unsigned xb_xcc_id() { return (unsigned)__builtin_amdgcn_s_getreg((3 << 11) | 20) & 0xFu; }
#define XB_SPIN(cond, bar) do { unsigned _sp = 0; while (cond) { __builtin_amdgcn_s_sleep(1); \
    if ((++_sp & 255u) == 0u) { if (xb_ld(&(bar)[XB_TMO])) break; if (_sp > XB_SPIN_CAP) { atomicAdd(&(bar)[XB_TMO], 1u); break; } } } } while (0)

struct XcdBarrier {
    unsigned ng;
    unsigned* bar; unsigned x;
    volatile LAS unsigned* st;
};

__device__ __forceinline__ XcdBarrier xcd_barrier_post(unsigned* bar, volatile LAS unsigned* st) {
    XcdBarrier b; b.ng = 0u; b.bar = bar; b.x = xb_xcc_id(); b.st = st;
    if (threadIdx.x == 0) (void)xb_add(&bar[XB_XCNT(b.x)], 1u);
    return b;
}
__device__ __forceinline__ void xcd_barrier_complete(unsigned* bar, unsigned x, unsigned& nloc, unsigned& nx, unsigned G) {
    unsigned sum, cnt, mine, sp = 0u;
    for (;;) {
        sum = 0u; cnt = 0u; mine = 0u;
#pragma unroll
        for (unsigned j = 0; j < 16; ++j) { const unsigned c = xb_ld(&bar[XB_XCNT(j)]); sum += c; cnt += (c > 0u) ? 1u : 0u; mine = (j == x) ? c : mine; }
        if (sum == G) break;
        __builtin_amdgcn_s_sleep(1);
        if ((++sp & 255u) == 0u) { if (xb_ld(&bar[XB_TMO])) break; if (sp > XB_SPIN_CAP) { atomicAdd(&bar[XB_TMO], 1u); break; } }
    }
    nloc = mine > 0u ? mine : 1u; nx = cnt > 0u ? cnt : 1u;
}

__device__ __forceinline__ void xcd_barrier(const XcdBarrier& b) {
    asm volatile("s_waitcnt vmcnt(0)" ::: "memory");
    __syncthreads();
    if (threadIdx.x == 0) {
        unsigned* bar = b.bar;
        __builtin_amdgcn_s_waitcnt(0);
        unsigned nloc = b.st[0], nx = b.st[1];
        if (nloc == 0u) { xcd_barrier_complete(bar, b.x, nloc, nx, b.ng); b.st[0] = nloc; b.st[1] = nx; }
        const unsigned old = xb_add(&bar[XB_XSUB(b.x)], 1u);
        const unsigned gen = old / nloc;
        if (old + 1u == (gen + 1u) * nloc) {
            if (!(nx == 1u && nloc == b.ng)) {
            __builtin_amdgcn_fence(__ATOMIC_RELEASE, "agent");
            }
            asm volatile("s_waitcnt vmcnt(0)" ::: "memory");
            if (nx != 1u) {
            const unsigned og = xb_add(&bar[XB_TOP], 1u);
            const unsigned tg = og / nx;
            if (og + 1u == (tg + 1u) * nx) xb_add(&bar[XB_TOPGEN], 1u);
            else XB_SPIN(xb_ld(&bar[XB_TOPGEN]) == tg, bar);
            }
            __builtin_amdgcn_fence(__ATOMIC_ACQUIRE, "agent");
            xb_add(&bar[XB_XGEN(b.x)], 1u);
            asm volatile("s_waitcnt vmcnt(0)" ::: "memory");
        } else {
            XB_SPIN(xb_ld(&bar[XB_XGEN(b.x)]) == gen, bar);
            __builtin_amdgcn_fence(__ATOMIC_ACQUIRE, "agent");
            asm volatile("s_waitcnt vmcnt(0)" ::: "memory");
        }
    }
    __syncthreads();
}


__global__ void __launch_bounds__(512) hybrid_fwd(Args a0) {
    extern __shared__ __attribute__((aligned(16))) unsigned char lds[];
    cg::grid_group grid = cg::this_grid();
    PG8_LAS unsigned char* glds = (PG8_LAS unsigned char*)lds;
    const int wave0 = __builtin_amdgcn_readfirstlane(threadIdx.x >> 6);
    volatile LAS unsigned* bst = (volatile LAS unsigned*)((LAS unsigned char*)lds + (LDS_BYTES - 64));
    if (threadIdx.x < 4) bst[threadIdx.x] = 0u;
    __syncthreads();
    const int grp = blockIdx.x & 7, vb = blockIdx.x >> 3, vg = gridDim.x >> 3;
    const unsigned bx_ = xcd_barrier_post((unsigned*)(a0.ws + WS_BAR), bst).x;
    (void)xcd_barrier_post((unsigned*)(a0.ws + WS_CTL2) + 4096 * grp, bst + 2);
    { const int tid = threadIdx.x, lane = tid & 63;
      prologue(a0, lds, tid, lane, wave0, 0, (int)blockIdx.x, (int)gridDim.x, 0, 10752); }
    { XcdBarrier bb; bb.ng = gridDim.x; bb.bar = (unsigned*)(a0.ws + WS_BAR); bb.x = bx_; bb.st = bst; xcd_barrier(bb); }
    if (a0.ws == nullptr) grid.sync();
    { const int tid = threadIdx.x, lane = tid & 63; prologue(a0, lds, tid, lane, wave0, 1, vb, vg, 10752 + 192 * grp * (grp - 1), 10752 + 192 * grp * (grp + 1)); }
    asm volatile("s_waitcnt vmcnt(0)" ::: "memory"); __syncthreads();
    if (threadIdx.x == 0) { __builtin_amdgcn_fence(__ATOMIC_RELEASE, "agent"); asm volatile("s_waitcnt vmcnt(0)" ::: "memory");
        __hip_atomic_fetch_add((unsigned*)(a0.ws + WS_CTL2) + 8 * 4096, 1u, __ATOMIC_RELAXED, __HIP_MEMORY_SCOPE_AGENT); }
    const int r0 = grp * (T / 8);

    for (int st = 0; st < 28; ++st) {
        const int l = st / 14, s = st % 14;
        int olane = __builtin_amdgcn_mbcnt_hi(~0u, __builtin_amdgcn_mbcnt_lo(~0u, 0u)); asm volatile("" : "+v"(olane));
        const int otid = wave0 * 64 + olane;
        unsigned long long kpi = (unsigned long long)__builtin_amdgcn_kernarg_segment_ptr(); asm volatile("" : "+s"(kpi));
        const __attribute__((address_space(4))) Args& a = *(const __attribute__((address_space(4))) Args*)kpi;
        unsigned char* ws = a.ws;
        const int tid = otid, lane = olane, wave = wave0;
        if (st == 14) {
            if (tid == 0) { unsigned sp = 0; while (__hip_atomic_load((unsigned*)(ws + WS_CTL2) + 8 * 4096, __ATOMIC_RELAXED, __HIP_MEMORY_SCOPE_AGENT) < gridDim.x && ++sp < (1u << 22)) __builtin_amdgcn_s_sleep(2);
                __builtin_amdgcn_fence(__ATOMIC_ACQUIRE, "agent"); asm volatile("s_waitcnt vmcnt(0)" ::: "memory"); }
            __syncthreads();
        }
        const size_t rg = (size_t)grp * (T / 8), cg0 = (size_t)grp * 256;
        bf16* XN = (bf16*)(ws + WS_XN);
        bf16* MX = (bf16*)((unsigned char*)a.out + (size_t)grp * 16 * MiB) - rg * DM;
        float* RS = (float*)(ws + WS_RS);
        unsigned char* dreg = ws + WS_D + (size_t)grp * 8 * MiB;
        bf16* Dd = (bf16*)dreg - rg * DM; float* OA = (float*)dreg - rg * 256; float* UBv = (float*)(dreg + 4 * MiB) - cg0 * 4096;
        unsigned char* areg = ws + WS_ACT + (size_t)grp * 22 * MiB;
        bf16* ACT = (bf16*)areg - rg * DFF; bf16* Z = (bf16*)areg - rg * INW; bf16* SG = (bf16*)areg - rg * DM;
        const float* COS = (const float*)(ws + WS_COS); const float* SIN = (const float*)(ws + WS_SIN);
        unsigned char* wl = ws + (size_t)l * WS_WL;
        const float* ng = a.ng + (size_t)l * 8 * DM;
        const size_t ro = (size_t)r0;
        if (s == 0 || s == 9) {
            pg8::Gemm g{XN + ro * DM, (const bf16*)(wl + (s == 0 ? OW_GU1 : OW_GU2)), T / 8, 2 * DFF, DM}; pg8::StaticOrder S; S.init(T / 8, 2 * DFF, vg, vb);
            pg8::EpiSwiglu E{ACT + ro * DFF, DFF, RS + ro};
            pg8::gemm_phase<pg8::EpiSwiglu, pg8::StaticOrder, true, true>(glds, g, S, E, otid, wave0);
        } else if (s == 1 || s == 10 || s == 3 || s == 7) {
            const int N = (s == 3) ? INW : DM, K = (s == 1 || s == 10) ? DFF : DM;
            const bf16* A = ((s == 3) ? XN : (s == 7 ? MX : ACT)) + ro * K;
            const bf16* B = (const bf16*)(wl + (s == 1 ? OW_D1 : s == 10 ? OW_D2 : s == 3 ? OW_IN : OW_OUT));
            pg8::Gemm g{A, B, T / 8, N, K}; pg8::StaticOrder S; S.init(T / 8, N, vg, vb);
            pg8::EpiPlain E{((s == 3) ? Z : Dd) + ro * N, N, (s == 3) ? RS + ro : nullptr};
            pg8::gemm_phase<pg8::EpiPlain, pg8::StaticOrder, true, true>(glds, g, S, E, otid, wave0);
        } else if (s == 2 || s == 8 || s == 11 || s == 13) {
            const int ia = (s == 2) ? 1 : (s == 8) ? 3 : (s == 11) ? 5 : 7;
            const float* ga = ng + ia * DM;
            const float scale = (s == 2 || s == 11) ? 0.5f : 1.0f;
            norm_phase(Dd, (s == 13) ? SG : nullptr, (st == 2) ? a.x : nullptr, XN, RS, (st == 27) ? a.out : nullptr, ga, scale, lane, wave, vb, vg, r0, T / 8);
        } else if (s == 4) {
            hgrn_a(Z, OA, (bf16*)(ws + WS_QD), UBv, (float*)(ws + WS_DV), a.lbl, l, lds, lane, wave, vb, vg, grp * 256, 256);
        } else if (s == 6) {
            hgrn_c((const bf16*)(ws + WS_SP), (const bf16*)(ws + WS_QD), OA, Z, MX, a.hgn + l * 64, lane, wave, vb, vg, grp * 256, 256);
        } else if (s == 5) {
            hgrn_b(UBv, (const float*)(ws + WS_DV), (bf16*)(ws + WS_SP), tid, vb, vg, grp * 4, 4);
            for (int u = vb; u < 64; u += vg) attn_unit(Z, MX, COS, SIN, a.sinks + l * 8, grp * 64 + u, lds, tid, lane, wave);
            for (int u = vb; u < 32; u += vg) sgu_unit(Z, MX, (const bf16*)(wl + OW_SW), a.sgln + l * 256, a.sgb + l * 512, grp * 32 + u, lds, tid, lane, wave);
        } else {
            { pg8::Gemm g{XN + ro * DM, (const bf16*)(wl + OW_G), T / 8, DM, DM}; pg8::StaticOrder S; S.init(T / 8, DM, vg, vb);
              pg8::EpiPlain E{SG + ro * DM, DM, RS + ro};
              pg8::gemm_phase<pg8::EpiPlain, pg8::StaticOrder, true, true>(glds, g, S, E, otid, wave0); }
            { pg8::Gemm g{(const bf16*)(ws + WS_PB) + ((size_t)l * T + ro) * PLE, (const bf16*)(wl + OW_P), T / 8, DM, PLE}; pg8::StaticOrder S; S.init(T / 8, DM, vg, vb);
              pg8::EpiPlain E{Dd + ro * DM, DM, nullptr};
              pg8::gemm_phase<pg8::EpiPlain, pg8::StaticOrder, true, true>(glds, g, S, E, otid, wave0); }
        }
        if (st != 27) { XcdBarrier bb; bb.ng = (unsigned)vg; bb.bar = (unsigned*)(ws + WS_CTL2) + 4096 * grp; bb.x = bx_; bb.st = bst + 2; xcd_barrier(bb); }
    }
}

extern "C" void kernel_launch(void* const* d_in, const int* in_sizes, int n_in, void* d_out, int out_size, void* d_ws, size_t ws_size, hipStream_t stream) {
    static int grid = 0;
    if (grid == 0) {
        if (n_in != 18 || ws_size < WS_END) { fprintf(stderr, "kernel_launch: unexpected n_in %d / ws_size %zu\n", n_in, ws_size); grid = -1; return; }
        int dev = 0, cus = 0, per_cu = 0;
        (void)hipGetDevice(&dev);
        (void)hipDeviceGetAttribute(&cus, hipDeviceAttributeMultiprocessorCount, dev);
        if (hipFuncSetAttribute((const void*)hybrid_fwd, hipFuncAttributeMaxDynamicSharedMemorySize, LDS_BYTES) != hipSuccess) { fprintf(stderr, "kernel_launch: hipFuncSetAttribute failed\n"); grid = -1; return; }
        if (hipOccupancyMaxActiveBlocksPerMultiprocessor(&per_cu, (const void*)hybrid_fwd, 512, LDS_BYTES) != hipSuccess || per_cu < 1) { fprintf(stderr, "kernel_launch: occupancy query gave %d\n", per_cu); per_cu = 1; }
        (void)hipGetLastError();
        grid = cus * per_cu;
        if (grid != 256) { fprintf(stderr, "kernel_launch: this kernel needs exactly 256 co-resident workgroups, got %d\n", grid); grid = -1; return; }
        fprintf(stderr, "kernel_launch: grid %d (cus %d x %d)\n", grid, cus, per_cu);
    }
    if (grid < 0) return;
    Args a{};
    a.x = (const float*)d_in[0]; a.p = (const float*)d_in[1]; a.pos = (const int*)d_in[2]; a.ng = (const float*)d_in[3]; a.w_in = (const float*)d_in[4]; a.w_out = (const float*)d_in[5];
    a.gu1 = (const float*)d_in[6]; a.d1 = (const float*)d_in[7]; a.gu2 = (const float*)d_in[8]; a.d2 = (const float*)d_in[9]; a.lbl = (const float*)d_in[10]; a.hgn = (const float*)d_in[11];
    a.sinks = (const float*)d_in[12]; a.sgln = (const float*)d_in[13]; a.sgw = (const float*)d_in[14]; a.sgb = (const float*)d_in[15]; a.plep = (const float*)d_in[16]; a.pleg = (const float*)d_in[17];
    a.out = (float*)d_out; a.ws = (unsigned char*)d_ws;
    if (hipMemsetAsync((char*)d_ws + WS_BAR, 0, 16384 + 9 * 16384 + 4096, stream) != hipSuccess) { fprintf(stderr, "kernel_launch: memset failed\n"); return; }
    void* args[] = {&a};
    hipError_t e = hipLaunchCooperativeKernel((const void*)hybrid_fwd, dim3(grid), dim3(512), args, LDS_BYTES, stream);
    if (e != hipSuccess) fprintf(stderr, "kernel_launch: cooperative launch failed: %s (grid %d)\n", hipGetErrorString(e), grid);
}
```
